# Optimizing an MI355X kernel written in HIP

```python
import math
import jax, jax.numpy as jnp
from jax import lax
import numpy as np

D_MODEL = 1024
BATCH = 8
SEQ = 4096
DEPTH = 1

HEAD_DIM = 64
N_MOBA_HEADS = 6
N_SB_HEADS = 6
N_MEM_HEADS = 4
MOBA_WIDTH = N_MOBA_HEADS * HEAD_DIM
SB_WIDTH = N_SB_HEADS * HEAD_DIM
MEM_WIDTH = N_MEM_HEADS * HEAD_DIM
N_MEM = 256
MOBA_BLOCK = 256
MOBA_TOPK = 3
MOBA_QCHUNK = 64
SB_QBLOCK = 128
N_BUCKETS = 32
MAX_DISTANCE = 128
N_GROUPS = 4
EXPERTS_PER_GROUP = 8
N_EXPERTS = N_GROUPS * EXPERTS_PER_GROUP
EXPERT_TOPK = 2
D_EXPERT = 512
MOE_BLOCK = 256
N_BRANCH = 3
PROJ_WIDTH = 3 * MOBA_WIDTH + 3 * SB_WIDTH + MEM_WIDTH + N_BRANCH * D_MODEL
DEEPNORM_ALPHA = (2.0 * DEPTH) ** 0.25
DEEPNORM_BETA = (8.0 * DEPTH) ** -0.25
LN_EPS = 1e-5
NEG = -1e30

kernel_name = "hybrid_moba_stickbreak_memxattn_hiermoe_deepnorm"


def layer_norm(x, g, b):
    xf = x.astype(jnp.float32)
    mu = xf.mean(-1, keepdims=True)
    var = jnp.square(xf - mu).mean(-1, keepdims=True)
    return ((xf - mu) * lax.rsqrt(var + LN_EPS) * g + b).astype(x.dtype)


def t5_bucket(rel):
    rel = jnp.maximum(rel, 0)
    max_exact = N_BUCKETS // 2
    rel_f = jnp.maximum(rel, 1).astype(jnp.float32)
    large = max_exact + (jnp.log(rel_f / max_exact) / math.log(MAX_DISTANCE / max_exact)
                         * (N_BUCKETS - max_exact)).astype(jnp.int32)
    large = jnp.minimum(large, N_BUCKETS - 1)
    return jnp.where(rel < max_exact, rel, large)


def split_heads(t, n_heads):
    B, S, _ = t.shape
    return t.reshape(B, S, n_heads, HEAD_DIM).transpose(0, 2, 1, 3)


def merge_heads(t):
    B, H, S, dh = t.shape
    return t.transpose(0, 2, 1, 3).reshape(B, S, H * dh)


def moba_attention(q, k, v, rel_bias):
    B, H, S, dh = q.shape
    dtype = q.dtype
    q, k, v = (t.astype(jnp.float32) for t in (q, k, v))
    scale = dh ** -0.5
    nb = -(-S // MOBA_BLOCK)
    pad = nb * MOBA_BLOCK - S
    k = jnp.pad(k, ((0, 0), (0, 0), (0, pad), (0, 0)))
    v = jnp.pad(v, ((0, 0), (0, 0), (0, pad), (0, 0)))
    kb = k.reshape(B, H, nb, MOBA_BLOCK, dh)
    vb = v.reshape(B, H, nb, MOBA_BLOCK, dh)
    k_mean = kb.mean(axis=3)
    topk = min(MOBA_TOPK, nb - 1)
    bias_ht = rel_bias.T.astype(jnp.float32)
    blk_ar = jnp.arange(MOBA_BLOCK)
    b_idx = jnp.arange(B)[:, None, None]
    h_idx = jnp.arange(H)[None, :, None]
    h_idx4 = jnp.arange(H)[None, :, None, None]

    def partial_attn(s, vals, eq):
        m = s.max(-1)
        p = jnp.exp(s - m[..., None])
        return m, p.sum(-1), jnp.einsum(eq, p, vals)

    def chunk(args):
        c, qc = args
        start = c * MOBA_QCHUNK
        q_pos = start + jnp.arange(MOBA_QCHUNK)
        own = start // MOBA_BLOCK
        k_own = lax.dynamic_index_in_dim(kb, own, axis=2, keepdims=False)
        v_own = lax.dynamic_index_in_dim(vb, own, axis=2, keepdims=False)
        rel = q_pos[:, None] - (own * MOBA_BLOCK + blk_ar)[None, :]
        s = jnp.einsum('bhqd,bhkd->bhqk', qc, k_own) * scale + bias_ht[:, t5_bucket(rel)][None]
        s = jnp.where(rel >= 0, s, NEG)
        stats = [partial_attn(s, v_own, 'bhqk,bhkd->bhqd')]
        if topk > 0:
            gate = jnp.einsum('bhqd,bhnd->bhqn', qc, k_mean)
            gate = jnp.where(jnp.arange(nb) < own, gate, NEG)
            _, sel = lax.top_k(gate, topk)
            for r in range(topk):
                idx = sel[..., r]
                k_sel = kb[b_idx, h_idx, idx]
                v_sel = vb[b_idx, h_idx, idx]
                rel = q_pos[:, None] - (idx[..., None] * MOBA_BLOCK + blk_ar)
                s = (jnp.einsum('bhqd,bhqkd->bhqk', qc, k_sel) * scale
                     + bias_ht[h_idx4, t5_bucket(rel)])
                s = jnp.where(r < own, s, NEG)
                stats.append(partial_attn(s, v_sel, 'bhqk,bhqkd->bhqd'))
        m = jnp.stack([st[0] for st in stats])
        l = jnp.stack([st[1] for st in stats])
        o = jnp.stack([st[2] for st in stats])
        w = jnp.exp(m - m.max(0))
        return (w[..., None] * o).sum(0) / (w * l).sum(0)[..., None]

    nc = S // MOBA_QCHUNK
    qcs = q.reshape(B, H, nc, MOBA_QCHUNK, dh).transpose(2, 0, 1, 3, 4)
    out = lax.map(chunk, (jnp.arange(nc), qcs))
    return out.transpose(1, 2, 0, 3, 4).reshape(B, H, S, dh).astype(dtype)


def stick_breaking_attention(q, k, v):
    B, H, S, dh = q.shape
    dtype = q.dtype
    scale = dh ** -0.5
    kf = k.astype(jnp.float32)
    vf = v.astype(jnp.float32)
    nqb = S // SB_QBLOCK
    qbs = q.astype(jnp.float32).reshape(B, H, nqb, SB_QBLOCK, dh).transpose(2, 0, 1, 3, 4)
    k_pos = jnp.arange(S)

    def block(args):
        i, qb = args
        q_pos = i * SB_QBLOCK + jnp.arange(SB_QBLOCK)
        strict = k_pos[None, :] < q_pos[:, None]
        z = jnp.einsum('bhqd,bhkd->bhqk', qb, kf) * scale
        log_keep = jnp.where(strict, jax.nn.log_sigmoid(-z), 0.0)
        log_stick = lax.cumsum(log_keep, axis=3, reverse=True) - log_keep
        a = jnp.where(strict, jnp.exp(jax.nn.log_sigmoid(z) + log_stick), 0.0)
        return jnp.einsum('bhqk,bhkd->bhqd', a, vf)

    out = lax.map(block, (jnp.arange(nqb), qbs))
    return out.transpose(1, 2, 0, 3, 4).reshape(B, H, S, dh).astype(dtype)


def memory_attention(q, k, v):
    scale = q.shape[-1] ** -0.5
    s = jnp.einsum('bhqd,bhmd->bhqm', q.astype(jnp.float32), k.astype(jnp.float32)) * scale
    p = jax.nn.softmax(s, axis=-1)
    return jnp.einsum('bhqm,bhmd->bhqd', p, v.astype(jnp.float32)).astype(q.dtype)


def hybrid_mixer(x, mem, w_in, w_mem_kv, rel_bias, w_br_moba, w_br_sb, w_br_mem, w_out):
    sizes = (MOBA_WIDTH, MOBA_WIDTH, MOBA_WIDTH, SB_WIDTH, SB_WIDTH, SB_WIDTH, MEM_WIDTH)
    offsets = []
    acc = 0
    for sz in sizes:
        acc += sz
        offsets.append(acc)
    proj = x @ w_in
    q_a, k_a, v_a, q_b, k_b, v_b, q_m, gate_logits = jnp.split(proj, offsets, axis=-1)
    y_a = merge_heads(moba_attention(split_heads(q_a, N_MOBA_HEADS), split_heads(k_a, N_MOBA_HEADS),
                                     split_heads(v_a, N_MOBA_HEADS), rel_bias))
    y_b = merge_heads(stick_breaking_attention(split_heads(q_b, N_SB_HEADS), split_heads(k_b, N_SB_HEADS),
                                               split_heads(v_b, N_SB_HEADS)))
    k_m, v_m = jnp.split(mem @ w_mem_kv, 2, axis=-1)
    y_m = merge_heads(memory_attention(split_heads(q_m, N_MEM_HEADS), split_heads(k_m, N_MEM_HEADS),
                                       split_heads(v_m, N_MEM_HEADS)))
    B, S, _ = x.shape
    gates = jax.nn.sigmoid(gate_logits.reshape(B, S, N_BRANCH, D_MODEL))
    merged = (gates[:, :, 0] * (y_a @ w_br_moba)
              + gates[:, :, 1] * (y_b @ w_br_sb)
              + gates[:, :, 2] * (y_m @ w_br_mem))
    return merged @ w_out


def hierarchical_moe(x, w_router_group, b_router_group, w_router_expert, b_router_expert,
                     w_gate, w_up, w_down):
    B, S, D = x.shape
    xt = x.reshape(-1, D)
    N = xt.shape[0]
    g_prob = jax.nn.softmax((xt @ w_router_group + b_router_group).astype(jnp.float32), axis=-1)
    g_p, g_idx = lax.top_k(g_prob, 1)
    e_logits = (xt @ w_router_expert + b_router_expert).astype(jnp.float32)
    e_logits = e_logits.reshape(N, N_GROUPS, EXPERTS_PER_GROUP)
    e_in_group = jnp.take_along_axis(e_logits, g_idx[:, :, None], axis=1)[:, 0]
    top_l, top_i = lax.top_k(e_in_group, EXPERT_TOPK)
    gate = g_p * jax.nn.softmax(top_l, axis=-1)
    expert = g_idx * EXPERTS_PER_GROUP + top_i

    M = N * EXPERT_TOPK
    flat_e = expert.reshape(M)
    flat_tok = jnp.arange(M) // EXPERT_TOPK
    flat_gate = gate.reshape(M)
    order = jnp.argsort(flat_e)
    e_sorted = flat_e[order]
    tok_sorted = flat_tok[order]
    gate_sorted = flat_gate[order]
    counts = jnp.bincount(flat_e, length=N_EXPERTS)
    padded = (counts + MOE_BLOCK - 1) // MOE_BLOCK * MOE_BLOCK
    start = jnp.cumsum(counts) - counts
    pstart = jnp.cumsum(padded) - padded
    dest = pstart[e_sorted] + (jnp.arange(M) - start[e_sorted])
    n_blocks = -(-M // MOE_BLOCK) + N_EXPERTS
    P = n_blocks * MOE_BLOCK
    x_pad = jnp.zeros((P, D), xt.dtype).at[dest].set(xt[tok_sorted])
    block_expert = jnp.clip(jnp.searchsorted(pstart + padded, jnp.arange(n_blocks) * MOE_BLOCK, side='right'),
                            0, N_EXPERTS - 1)

    def expert_block(args):
        xb, e = args
        h = jax.nn.silu(xb @ w_gate[e]) * (xb @ w_up[e])
        return h @ w_down[e]

    y_pad = lax.map(expert_block, (x_pad.reshape(n_blocks, MOE_BLOCK, D), block_expert)).reshape(P, D)
    y_assign = y_pad[dest] * gate_sorted[:, None].astype(y_pad.dtype)
    out = jax.ops.segment_sum(y_assign, tok_sorted, num_segments=N)
    return out.reshape(B, S, D)


def setup_inputs(seed: int = 0) -> dict:
    key = jax.random.key(seed)
    ks = jax.random.split(key, 20)
    f32 = jnp.float32
    L, D = DEPTH, D_MODEL

    def nrm(k, shape, scale):
        return jax.random.normal(k, shape, f32) * scale

    return {
        "x": nrm(ks[0], (BATCH, SEQ, D), 1.0),
        "mem": nrm(ks[1], (BATCH, N_MEM, D), 1.0),
        "w_in": nrm(ks[2], (L, D, PROJ_WIDTH), D ** -0.5),
        "w_mem_kv": nrm(ks[3], (L, D, 2 * MEM_WIDTH), D ** -0.5),
        "rel_bias": nrm(ks[4], (N_BUCKETS, N_MOBA_HEADS), 0.5),
        "w_br_moba": nrm(ks[5], (L, MOBA_WIDTH, D), MOBA_WIDTH ** -0.5),
        "w_br_sb": nrm(ks[6], (L, SB_WIDTH, D), SB_WIDTH ** -0.5),
        "w_br_mem": nrm(ks[7], (L, MEM_WIDTH, D), MEM_WIDTH ** -0.5),
        "w_out": nrm(ks[8], (L, D, D), D ** -0.5 * DEEPNORM_BETA),
        "ln1_g": 1.0 + nrm(ks[9], (L, D), 0.02),
        "ln1_b": nrm(ks[10], (L, D), 0.02),
        "w_router_group": nrm(ks[11], (L, D, N_GROUPS), D ** -0.5),
        "b_router_group": nrm(ks[12], (L, N_GROUPS), 0.01),
        "w_router_expert": nrm(ks[13], (L, D, N_EXPERTS), D ** -0.5),
        "b_router_expert": nrm(ks[14], (L, N_EXPERTS), 0.01),
        "w_gate": nrm(ks[15], (L, N_EXPERTS, D, D_EXPERT), D ** -0.5),
        "w_up": nrm(ks[16], (L, N_EXPERTS, D, D_EXPERT), D ** -0.5),
        "w_down": nrm(ks[17], (L, N_EXPERTS, D_EXPERT, D), D_EXPERT ** -0.5 * DEEPNORM_BETA),
        "ln2_g": 1.0 + nrm(ks[18], (L, D), 0.02),
        "ln2_b": nrm(ks[19], (L, D), 0.02),
    }


def reference(x, mem, w_in, w_mem_kv, rel_bias, w_br_moba, w_br_sb, w_br_mem, w_out, ln1_g, ln1_b,
              w_router_group, b_router_group, w_router_expert, b_router_expert,
              w_gate, w_up, w_down, ln2_g, ln2_b):
    for l in range(DEPTH):
        mix = hybrid_mixer(x, mem, w_in[l], w_mem_kv[l], rel_bias, w_br_moba[l], w_br_sb[l],
                           w_br_mem[l], w_out[l])
        x = layer_norm(DEEPNORM_ALPHA * x + mix, ln1_g[l], ln1_b[l])
        ffn = hierarchical_moe(x, w_router_group[l], b_router_group[l], w_router_expert[l],
                               b_router_expert[l], w_gate[l], w_up[l], w_down[l])
        x = layer_norm(DEEPNORM_ALPHA * x + ffn, ln2_g[l], ln2_b[l])
    return x
```

```cpp
#include <hip/hip_runtime.h>
#include <cstdio>
#include <cstdint>

#ifndef N_LAUNCH_PER_PHASE
#define N_LAUNCH_PER_PHASE 0
#endif
#ifndef FAST_GEMM
#define FAST_GEMM 0
#endif
#ifndef FAST_ATTN
#define FAST_ATTN 0
#endif

#define GAS __attribute__((address_space(1)))
#define LAS __attribute__((address_space(3)))
typedef unsigned short bf16;
typedef short bf16x8 __attribute__((ext_vector_type(8)));
typedef float f32x4 __attribute__((ext_vector_type(4)));
typedef float f32x2 __attribute__((ext_vector_type(2)));
typedef float f32x16 __attribute__((ext_vector_type(16)));
typedef unsigned u32x4 __attribute__((ext_vector_type(4)));
typedef unsigned u32x2 __attribute__((ext_vector_type(2)));

constexpr int BATCH = 8, SEQ = 4096, DM = 1024, NTOK = BATCH * SEQ;
constexpr int HD = 64, NH_A = 6, NH_B = 6, NH_M = 4, NMEM = 256;
constexpr int QKVW = 2560, GATEW = 3072, PROJW = QKVW + GATEW;
constexpr int C_QA = 0, C_KA = 384, C_VA = 768, C_QB = 1152, C_KB = 1536, C_VB = 1920, C_QM = 2304;
constexpr int NBLK = 16;
constexpr int NEXP = 32, DEXP = 512, NGRP = 4, EPG = 8;
constexpr int NASG = NTOK * 2;
constexpr int MAXTILES = NASG / 256 + NEXP;
constexpr float ALPHA = 1.189207115002721f;
constexpr float LN_EPS = 1e-5f;
constexpr float LOG2E = 1.4426950408889634f;
constexpr float C2 = 0.125f * LOG2E;
constexpr float NEGBIG = -1e30f;

constexpr size_t MiB = 1u << 20;
constexpr size_t WS_CTL = 0, CTL_ZERO_BYTES = 1 * MiB;
constexpr size_t WS_KMEAN = 1 * MiB;
constexpr size_t WS_WRT = 1 * MiB + 512 * 1024;
constexpr size_t WS_MEMKV = 2 * MiB;
constexpr size_t WS_MEMB = 4 * MiB;
constexpr size_t WS_LIST = 8 * MiB;
constexpr size_t WS_AGATE = 12 * MiB;
constexpr size_t WS_GATES = 16 * MiB;
constexpr size_t WS_X1 = 16 * MiB;
constexpr size_t WS_X1B = 144 * MiB;
constexpr size_t WS_Y = 144 * MiB;
constexpr size_t WS_QKV = 208 * MiB;
constexpr size_t WS_MERGED = 208 * MiB;
constexpr size_t WS_WGU = 272 * MiB;
constexpr size_t WS_WD = 336 * MiB;
constexpr size_t WS_XB = 368 * MiB;
constexpr size_t WS_YATT = 368 * MiB;
constexpr size_t WS_H = 368 * MiB;
constexpr size_t WS_WIN = 432 * MiB;
constexpr size_t WS_WMKV = 443 * MiB;
constexpr size_t WS_WBR = 444 * MiB;
constexpr size_t WS_WOUT = 446 * MiB;
constexpr size_t WS_END = 448 * MiB;
constexpr int CW_GCOUNT = 64;
constexpr int CW_WQ = 128;
constexpr int CW_BAR = 4096;

constexpr int RING_BYTES = 131072;
constexpr int P5_W_BYTES = 36 * 1024 * 4;
constexpr int LDS_MISC = P5_W_BYTES;
constexpr int LDS_CTL = LDS_MISC + 4096;
constexpr int LDS_BYTES = LDS_CTL + 512;
constexpr int NWAVES = 8, NTHREADS = 512;

__device__ __forceinline__ unsigned f2bf(float f) { unsigned u = __builtin_bit_cast(unsigned, f); return (u + 0x7fffu + ((u >> 16) & 1u)) >> 16; }
__device__ __forceinline__ unsigned pk2(float lo, float hi) { return f2bf(lo) | (f2bf(hi) << 16); }
__device__ __forceinline__ float bf2f(unsigned short b) { return __builtin_bit_cast(float, (unsigned)b << 16); }
__device__ __forceinline__ float bflo(unsigned w) { return __builtin_bit_cast(float, w << 16); }
__device__ __forceinline__ float bfhi(unsigned w) { return __builtin_bit_cast(float, w & 0xffff0000u); }
__device__ __forceinline__ float wave_sum(float v) {
#pragma unroll
    for (int o = 1; o < 64; o <<= 1) v += __shfl_xor(v, o);
    return v;
}
__device__ __forceinline__ float wave_max(float v) {
#pragma unroll
    for (int o = 1; o < 64; o <<= 1) v = fmaxf(v, __shfl_xor(v, o));
    return v;
}
__device__ __forceinline__ float fast_exp2(float x) { return __builtin_amdgcn_exp2f(x); }
__device__ __forceinline__ float fast_log2(float x) { return __builtin_amdgcn_logf(x); }
__device__ __forceinline__ int crow(int r, int hi) { return (r & 3) + 8 * (r >> 2) + 4 * hi; }
__device__ __forceinline__ int t5_bucket(int rel) {
    if (rel < 16) return rel;
    const int l = 16 + (int)(log2f((float)rel * (1.0f / 16.0f)) * (16.0f / 3.0f));
    return l < 31 ? l : 31;
}

#define XB_TMO      128
#define XB_XCNT(j)  (256  + 64 * (j))
#define XB_XSUB(j)  (1280 + 64 * (j))
#define XB_XGEN(j)  (2304 + 64 * (j))
#define XB_TOP      3328
#define XB_TOPGEN   3392
#define XCD_BAR_WORDS 3456
#define XB_SPIN_CAP (1u << 22)
__device__ __forceinline__ unsigned xb_ld(unsigned* p)              { return __hip_atomic_load(p, __ATOMIC_RELAXED, __HIP_MEMORY_SCOPE_AGENT); }
__device__ __forceinline__ unsigned xb_add(unsigned* p, unsigned v) { return __hip_atomic_fetch_add(p, v, __ATOMIC_RELAXED, __HIP_MEMORY_SCOPE_AGENT); }
__device__ __forceinline__ unsigned xb_xcc_id() { return (unsigned)__builtin_amdgcn_s_getreg((3 << 11) | 20) & 0xFu; }
#define XB_SPIN(cond, bar) do { unsigned _sp = 0; while (cond) { __builtin_amdgcn_s_sleep(1); \
    if ((++_sp & 255u) == 0u) { if (xb_ld(&(bar)[XB_TMO])) break; if (_sp > XB_SPIN_CAP) { atomicAdd(&(bar)[XB_TMO], 1u); break; } } } } while (0)
struct XcdBarrier { unsigned* bar; unsigned x; volatile LAS unsigned* st; };
__device__ __forceinline__ XcdBarrier xcd_barrier_post(unsigned* bar, volatile LAS unsigned* st) {
    XcdBarrier b; b.bar = bar; b.x = xb_xcc_id(); b.st = st;
    if (threadIdx.x == 0) (void)xb_add(&bar[XB_XCNT(b.x)], 1u);
    return b;
}
__device__ __forceinline__ void xcd_barrier_complete(unsigned* bar, unsigned x, unsigned& nloc, unsigned& nx) {
    const unsigned G = gridDim.x * gridDim.y * gridDim.z;
    unsigned sum, cnt, mine, sp = 0u;
    for (;;) {
        sum = 0u; cnt = 0u; mine = 0u;
#pragma unroll
        for (unsigned j = 0; j < 16; ++j) { const unsigned c = xb_ld(&bar[XB_XCNT(j)]); sum += c; cnt += (c > 0u) ? 1u : 0u; mine = (j == x) ? c : mine; }
        if (sum == G) break;
        __builtin_amdgcn_s_sleep(1);
        if ((++sp & 255u) == 0u) { if (xb_ld(&bar[XB_TMO])) break; if (sp > XB_SPIN_CAP) { atomicAdd(&bar[XB_TMO], 1u); break; } }
    }
    nloc = mine > 0u ? mine : 1u; nx = cnt > 0u ? cnt : 1u;
}
__device__ __forceinline__ void xcd_barrier(const XcdBarrier& b) {
    asm volatile("s_waitcnt vmcnt(0)" ::: "memory");
    __syncthreads();
    if (threadIdx.x == 0) {
        unsigned* bar = b.bar;
        __builtin_amdgcn_s_waitcnt(0);
        unsigned nloc = b.st[0], nx = b.st[1];
        if (nloc == 0u) { xcd_barrier_complete(bar, b.x, nloc, nx); b.st[0] = nloc; b.st[1] = nx; }
        const unsigned old = xb_add(&bar[XB_XSUB(b.x)], 1u);
        const unsigned gen = old / nloc;
        if (old + 1u == (gen + 1u) * nloc) {
            __builtin_amdgcn_fence(__ATOMIC_RELEASE, "agent");
            asm volatile("s_waitcnt vmcnt(0)" ::: "memory");
            const unsigned og = xb_add(&bar[XB_TOP], 1u);
            const unsigned tg = og / nx;
            if (og + 1u == (tg + 1u) * nx) xb_add(&bar[XB_TOPGEN], 1u);
            else XB_SPIN(xb_ld(&bar[XB_TOPGEN]) == tg, bar);
            __builtin_amdgcn_fence(__ATOMIC_ACQUIRE, "agent");
            xb_add(&bar[XB_XGEN(b.x)], 1u);
            asm volatile("s_waitcnt vmcnt(0)" ::: "memory");
        } else {
            XB_SPIN(xb_ld(&bar[XB_XGEN(b.x)]) == gen, bar);
            __builtin_amdgcn_fence(__ATOMIC_ACQUIRE, "agent");
            asm volatile("s_waitcnt vmcnt(0)" ::: "memory");
        }
    }
    __syncthreads();
}

struct Args { const float* in[20]; float* out; unsigned char* ws; int ph_lo, ph_hi; };
struct Frame {
    LAS unsigned char* lds;
    unsigned* ctl;
    int tid, lane, wave, G, bid;
    unsigned char* ws;
    float* out;
};
enum { I_X = 0, I_MEM, I_WIN, I_WMKV, I_RELB, I_WBA, I_WBB, I_WBM, I_WOUT, I_LN1G, I_LN1B, I_WRG, I_BRG, I_WRE, I_BRE, I_WG, I_WU, I_WD, I_LN2G, I_LN2B };

__device__ __forceinline__ void transpose_item(const float* W, size_t srcN, int k0, int n0, bf16* WT, size_t ldt, size_t drow0, int dcol0, LAS float* scr, int lane) {
#pragma unroll 8
    for (int i = 0; i < 32; ++i) { const int kk = 2 * i + (lane >> 5); scr[kk * 33 + (lane & 31)] = W[(size_t)(k0 + kk) * srcN + n0 + (lane & 31)]; }
    asm volatile("s_waitcnt lgkmcnt(0)" ::: "memory");
    const int c = lane & 7;
#pragma unroll
    for (int j = 0; j < 4; ++j) { const int n = (lane >> 3) + 8 * j; const LAS float* s = scr + (8 * c) * 33 + n;
        u32x4 o; o.x = pk2(s[0 * 33], s[1 * 33]); o.y = pk2(s[2 * 33], s[3 * 33]); o.z = pk2(s[4 * 33], s[5 * 33]); o.w = pk2(s[6 * 33], s[7 * 33]);
        *(u32x4*)(WT + (drow0 + n) * ldt + dcol0 + k0 + 8 * c) = o; }
    asm volatile("s_waitcnt lgkmcnt(0)" ::: "memory");
}
__device__ __forceinline__ void convert_rows_bf16(const float* src, bf16* dst, size_t n_elems, int gthread, int nthreads) {
    const size_t nv = n_elems / 8;
    for (size_t i = gthread; i < nv; i += nthreads) {
        const f32x4 a = *(const f32x4*)(src + i * 8), b = *(const f32x4*)(src + i * 8 + 4);
        u32x4 o; o.x = pk2(a.x, a.y); o.y = pk2(a.z, a.w); o.z = pk2(b.x, b.y); o.w = pk2(b.z, b.w);
        *(u32x4*)(dst + i * 8) = o;
    }
}
__device__ __forceinline__ void p0_prologue(Frame& F, const Args& A) {
    LAS float* scr = (LAS float*)(F.lds + F.wave * 16384);
    const int gw = F.bid * NWAVES + F.wave, NGW = F.G * NWAVES;
    const int gt = F.bid * NTHREADS + F.tid, NGT = F.G * NTHREADS;
    bf16* WIN = (bf16*)(F.ws + WS_WIN); bf16* WMKV = (bf16*)(F.ws + WS_WMKV); bf16* WBR = (bf16*)(F.ws + WS_WBR); bf16* WOUT = (bf16*)(F.ws + WS_WOUT);
    constexpr int I_IN = 16 * (PROJW / 32), I_MK = 16 * (512 / 32), I_BA = 6 * 32, I_BB = 6 * 32, I_BM = 4 * 32, I_WO = 16 * 32;
    constexpr int NITEMS = I_IN + I_MK + I_BA + I_BB + I_BM + I_WO;
    for (int it = gw; it < NITEMS; it += NGW) {
        int r = it;
        if (r < I_IN) { const int nb = PROJW / 32; transpose_item(A.in[I_WIN], PROJW, 64 * (r / nb), 32 * (r % nb), WIN, 1024, 32 * (r % nb), 0, scr, F.lane); continue; } r -= I_IN;
        if (r < I_MK) { const int nb = 16; transpose_item(A.in[I_WMKV], 512, 64 * (r / nb), 32 * (r % nb), WMKV, 1024, 32 * (r % nb), 0, scr, F.lane); continue; } r -= I_MK;
        if (r < I_BA) { const int nb = 32; transpose_item(A.in[I_WBA], 1024, 64 * (r / nb), 32 * (r % nb), WBR, 1024, 32 * (r % nb), 0, scr, F.lane); continue; } r -= I_BA;
        if (r < I_BB) { const int nb = 32; transpose_item(A.in[I_WBB], 1024, 64 * (r / nb), 32 * (r % nb), WBR, 1024, 32 * (r % nb), 384, scr, F.lane); continue; } r -= I_BB;
        if (r < I_BM) { const int nb = 32; transpose_item(A.in[I_WBM], 1024, 64 * (r / nb), 32 * (r % nb), WBR, 1024, 32 * (r % nb), 768, scr, F.lane); continue; } r -= I_BM;
        { const int nb = 32; transpose_item(A.in[I_WOUT], 1024, 64 * (r / nb), 32 * (r % nb), WOUT, 1024, 32 * (r % nb), 0, scr, F.lane); }
    }
    convert_rows_bf16(A.in[I_X], (bf16*)(F.ws + WS_XB), (size_t)NTOK * DM, gt, NGT);
    convert_rows_bf16(A.in[I_MEM], (bf16*)(F.ws + WS_MEMB), (size_t)BATCH * NMEM * DM, gt, NGT);
    float* WRT = (float*)(F.ws + WS_WRT);
    for (int i = gt; i < 36 * 1024; i += NGT) { const int o = i >> 10, k = i & 1023; WRT[i] = o < 4 ? A.in[I_WRG][k * 4 + o] : A.in[I_WRE][k * 32 + (o - 4)]; }
    if (gt < 36) WRT[36 * 1024 + gt] = gt < 4 ? A.in[I_BRG][gt] : A.in[I_BRE][gt - 4];
}
__device__ __forceinline__ void convert_experts(Frame& F, const Args& A) {
    LAS float* scr = (LAS float*)(F.lds + F.wave * 16384);
    const int gw = F.bid * NWAVES + F.wave, NGW = F.G * NWAVES;
    bf16* WGU = (bf16*)(F.ws + WS_WGU); bf16* WD = (bf16*)(F.ws + WS_WD);
    constexpr int PER_GU = 16 * 16;
    constexpr int PER_D = 8 * 32;
    constexpr int NIT = NEXP * (2 * PER_GU + PER_D);
    for (int it = gw; it < NIT; it += NGW) {
        const int e = it / (2 * PER_GU + PER_D); int r = it % (2 * PER_GU + PER_D);
        if (r < 2 * PER_GU) { const int up = r / PER_GU; r %= PER_GU; const int kb = r / 16, nb = r % 16, n0 = 32 * nb;
            const float* src = (up ? A.in[I_WU] : A.in[I_WG]) + (size_t)e * 1024 * 512;
            const size_t drow0 = (size_t)e * 1024 + (n0 / 128) * 256 + up * 128 + (n0 % 128);
            transpose_item(src, 512, 64 * kb, n0, WGU, 1024, drow0, 0, scr, F.lane);
        } else { r -= 2 * PER_GU; const int kb = r / 32, nb = r % 32;
            transpose_item(A.in[I_WD] + (size_t)e * 512 * 1024, 1024, 64 * kb, 32 * nb, WD, 512, (size_t)e * 1024 + 32 * nb, 0, scr, F.lane); }
    }
}

template <class AF, class BF, class EF>
__device__ __forceinline__ void sg_phase(Frame& F, int mt, int nt, int K, AF arow, BF brow, EF epi) {
    const int gw = F.bid * NWAVES + F.wave, NGW = F.G * NWAVES, r = F.lane & 31, h = F.lane >> 5;
    for (int tile = gw; tile < mt * nt; tile += NGW) {
        const int tm = tile / nt, tn = tile % nt;
        const bf16* ap = arow(tm * 32 + r) + 8 * h;
        const bf16* bp = brow(tn * 32 + r) + 8 * h;
        f32x16 acc = {};
        for (int k = 0; k < K; k += 16) {
            const bf16x8 a = *(const bf16x8*)(ap + k), b = *(const bf16x8*)(bp + k);
            acc = __builtin_amdgcn_mfma_f32_32x32x16_bf16(a, b, acc, 0, 0, 0);
        }
#pragma unroll
        for (int i = 0; i < 16; ++i) epi(tm * 32 + crow(i, h), tn * 32 + r, acc[i]);
    }
}

__device__ __forceinline__ float sigmoid_clamped(float v) { const float s = __builtin_amdgcn_rcpf(1.0f + fast_exp2(-v * LOG2E)); return fmaxf(s, 1e-18f); }
__device__ __forceinline__ bool is_qcol(int c) { return c < C_KA || (c >= C_QB && c < C_KB) || c >= C_QM; }
__device__ __forceinline__ void p1_proj_simple(Frame& F, const Args& A) {
    const bf16* XB = (const bf16*)(F.ws + WS_XB); const bf16* WIN = (const bf16*)(F.ws + WS_WIN);
    bf16* QKV = (bf16*)(F.ws + WS_QKV); bf16* GT = (bf16*)(F.ws + WS_GATES);
    sg_phase(F, NTOK / 32, PROJW / 32, DM,
        [&](int r) { return XB + (size_t)r * DM; }, [&](int c) { return WIN + (size_t)c * DM; },
        [&](int row, int col, float v) {
            if (col < QKVW) QKV[(size_t)row * QKVW + col] = (bf16)f2bf(is_qcol(col) ? v * C2 : v);
            else GT[(size_t)row * GATEW + (col - QKVW)] = (bf16)f2bf(sigmoid_clamped(v)); });
    const bf16* MB = (const bf16*)(F.ws + WS_MEMB); const bf16* WM = (const bf16*)(F.ws + WS_WMKV); bf16* MKV = (bf16*)(F.ws + WS_MEMKV);
    sg_phase(F, BATCH * NMEM / 32, 512 / 32, DM,
        [&](int r) { return MB + (size_t)r * DM; }, [&](int c) { return WM + (size_t)c * DM; },
        [&](int row, int col, float v) { MKV[(size_t)row * 512 + col] = (bf16)f2bf(v); });
}
__device__ __forceinline__ void p1b_kmean(Frame& F, const Args& A) {
    const bf16* QKV = (const bf16*)(F.ws + WS_QKV); float* KM = (float*)(F.ws + WS_KMEAN);
    for (int u = F.bid; u < BATCH * NBLK; u += F.G) {
        if (F.tid < 384) { const bf16* p = QKV + (size_t)u * 256 * QKVW + C_KA + F.tid; float s = 0.f;
            for (int r = 0; r < 256; ++r) s += bf2f(p[(size_t)r * QKVW]);
            KM[u * 384 + F.tid] = s * (1.0f / 256.0f); }
    }
}

struct RowAcc {
    float m, l; float o[64];
    __device__ __forceinline__ void init() { m = NEGBIG; l = 0.f;
#pragma unroll
        for (int d = 0; d < 64; ++d) o[d] = 0.f; }
    __device__ __forceinline__ void add(float s, const bf16* vrow) {
        if (s > m) { const float f = fast_exp2(m - s); l *= f;
#pragma unroll
            for (int d = 0; d < 64; ++d) o[d] *= f;
            m = s; }
        const float p = fast_exp2(s - m); l += p;
#pragma unroll
        for (int c = 0; c < 8; ++c) { const u32x4 w = *(const u32x4*)(vrow + 8 * c);
            o[8 * c + 0] += p * bflo(w.x); o[8 * c + 1] += p * bfhi(w.x); o[8 * c + 2] += p * bflo(w.y); o[8 * c + 3] += p * bfhi(w.y);
            o[8 * c + 4] += p * bflo(w.z); o[8 * c + 5] += p * bfhi(w.z); o[8 * c + 6] += p * bflo(w.w); o[8 * c + 7] += p * bfhi(w.w); }
    }
    __device__ __forceinline__ void finish(bf16* yrow, int lane) {
        const float M = wave_max(m); const float w = fast_exp2(m - M); const float L = wave_sum(l * w);
        float mine = 0.f;
#pragma unroll
        for (int d = 0; d < 64; ++d) { const float v = wave_sum(o[d] * w); if (lane == d) mine = v; }
        yrow[lane] = (bf16)f2bf(mine / L);
    }
};
__device__ __forceinline__ float dot64(const u32x4 (&q)[8], const bf16* krow) {
    float s = 0.f;
#pragma unroll
    for (int c = 0; c < 8; ++c) { const u32x4 w = *(const u32x4*)(krow + 8 * c);
        s += bflo(q[c].x) * bflo(w.x) + bfhi(q[c].x) * bfhi(w.x) + bflo(q[c].y) * bflo(w.y) + bfhi(q[c].y) * bfhi(w.y)
           + bflo(q[c].z) * bflo(w.z) + bfhi(q[c].z) * bfhi(w.z) + bflo(q[c].w) * bflo(w.w) + bfhi(q[c].w) * bfhi(w.w); }
    return s;
}
__device__ __forceinline__ void p2_attn_simple(Frame& F, const Args& A) {
    const bf16* QKV = (const bf16*)(F.ws + WS_QKV); bf16* Y = (bf16*)(F.ws + WS_YATT);
    const float* KM = (const float*)(F.ws + WS_KMEAN); const bf16* MKV = (const bf16*)(F.ws + WS_MEMKV);
    const float* relb = A.in[I_RELB];
    const int gw = F.bid * NWAVES + F.wave, NGW = F.G * NWAVES, lane = F.lane;
    constexpr int NHALL = NH_A + NH_B + NH_M;
    for (int task = gw; task < NTOK * NHALL; task += NGW) {
        const int hh = task % NHALL, tok = task / NHALL, b = tok / SEQ, t = tok % SEQ;
        u32x4 q[8];
        if (hh < NH_A) {
            const int h = hh, own = t >> 8;
            const bf16* qp = QKV + (size_t)tok * QKVW + C_QA + h * 64;
#pragma unroll
            for (int c = 0; c < 8; ++c) q[c] = *(const u32x4*)(qp + 8 * c);
            float g = NEGBIG;
            if (lane < own) { const float* km = KM + (size_t)(b * NBLK + lane) * 384 + h * 64; g = 0.f;
#pragma unroll
                for (int c = 0; c < 8; ++c) { g += bflo(q[c].x) * km[8 * c] + bfhi(q[c].x) * km[8 * c + 1] + bflo(q[c].y) * km[8 * c + 2] + bfhi(q[c].y) * km[8 * c + 3]
                                                 + bflo(q[c].z) * km[8 * c + 4] + bfhi(q[c].z) * km[8 * c + 5] + bflo(q[c].w) * km[8 * c + 6] + bfhi(q[c].w) * km[8 * c + 7]; } }
            int s1 = -1, s2 = -1, s3 = -1;
#pragma unroll
            for (int r = 0; r < 3; ++r) { if (r < own) { const float mx = wave_max(g); const unsigned long long bal = __ballot(g == mx); const int idx = __ffsll((long long)bal) - 1;
                if (r == 0) s1 = idx; else if (r == 1) s2 = idx; else s3 = idx; if (lane == idx) g = -3.0e38f; } }
            RowAcc A; A.init();
#pragma unroll
            for (int si = 0; si < 4; ++si) { const int blk = si == 0 ? own : (si == 1 ? s1 : (si == 2 ? s2 : s3)); if (blk < 0) continue;
                for (int c = 0; c < 4; ++c) { const int kpos = blk * 256 + c * 64 + lane; const int rel = t - kpos;
                    if (rel < 0) continue;
                    const bf16* kr = QKV + (size_t)(b * SEQ + kpos) * QKVW + C_KA + h * 64;
                    const float s = dot64(q, kr) + relb[t5_bucket(rel) * NH_A + h] * LOG2E;
                    A.add(s, QKV + (size_t)(b * SEQ + kpos) * QKVW + C_VA + h * 64); } }
            A.finish(Y + (size_t)tok * DM + h * 64, lane);
        } else if (hh < NH_A + NH_B) {
            const int h = hh - NH_A;
            const bf16* qp = QKV + (size_t)tok * QKVW + C_QB + h * 64;
#pragma unroll
            for (int c = 0; c < 8; ++c) q[c] = *(const u32x4*)(qp + 8 * c);
            float o[64];
#pragma unroll
            for (int d = 0; d < 64; ++d) o[d] = 0.f;
            float carry = 0.f;
            for (int base = t - 1; base >= 0; base -= 64) {
                const int s = base - lane; const bool valid = s >= 0;
                float z = 0.f, lk = 0.f, sp = 0.f;
                if (valid) { z = dot64(q, QKV + (size_t)(b * SEQ + s) * QKVW + C_KB + h * 64);
                    sp = fmaxf(z, 0.f) + fast_log2(1.0f + fast_exp2(-fabsf(z))); lk = -sp; }
                float pre = lk;
#pragma unroll
                for (int off = 1; off < 64; off <<= 1) { const float v = __shfl_up(pre, off); if (lane >= off) pre += v; }
                const float E = carry + pre - lk;
                if (valid) { const float a = fast_exp2(z - sp + E); const bf16* vr = QKV + (size_t)(b * SEQ + s) * QKVW + C_VB + h * 64;
#pragma unroll
                    for (int c = 0; c < 8; ++c) { const u32x4 w = *(const u32x4*)(vr + 8 * c);
                        o[8 * c + 0] += a * bflo(w.x); o[8 * c + 1] += a * bfhi(w.x); o[8 * c + 2] += a * bflo(w.y); o[8 * c + 3] += a * bfhi(w.y);
                        o[8 * c + 4] += a * bflo(w.z); o[8 * c + 5] += a * bfhi(w.z); o[8 * c + 6] += a * bflo(w.w); o[8 * c + 7] += a * bfhi(w.w); } }
                carry += __shfl(pre, 63);
                if (carry < -150.0f) break;
            }
            float mine = 0.f;
#pragma unroll
            for (int d = 0; d < 64; ++d) { const float v = wave_sum(o[d]); if (lane == d) mine = v; }
            Y[(size_t)tok * DM + 384 + h * 64 + lane] = (bf16)f2bf(mine);
        } else {
            const int h = hh - NH_A - NH_B;
            const bf16* qp = QKV + (size_t)tok * QKVW + C_QM + h * 64;
#pragma unroll
            for (int c = 0; c < 8; ++c) q[c] = *(const u32x4*)(qp + 8 * c);
            RowAcc A; A.init();
            for (int c = 0; c < 4; ++c) { const bf16* kr = MKV + (size_t)(b * NMEM + c * 64 + lane) * 512 + h * 64;
                A.add(dot64(q, kr), kr + 256); }
            A.finish(Y + (size_t)tok * DM + 768 + h * 64, lane);
        }
    }
}

__device__ __forceinline__ void p3_merge_simple(Frame& F, const Args& A) {
    const bf16* YA = (const bf16*)(F.ws + WS_YATT); const bf16* WBR = (const bf16*)(F.ws + WS_WBR); const bf16* GT = (const bf16*)(F.ws + WS_GATES);
    bf16* MG = (bf16*)(F.ws + WS_MERGED);
    const int gw = F.bid * NWAVES + F.wave, NGW = F.G * NWAVES, r = F.lane & 31, h = F.lane >> 5;
    for (int tile = gw; tile < (NTOK / 32) * (DM / 32); tile += NGW) {
        const int tm = tile / 32, tn = tile % 32;
        const bf16* ap = YA + (size_t)(tm * 32 + r) * DM + 8 * h; const bf16* bp = WBR + (size_t)(tn * 32 + r) * DM + 8 * h;
        f32x16 tot = {};
#pragma unroll 1
        for (int br = 0; br < 3; ++br) { const int k0 = br == 0 ? 0 : (br == 1 ? 384 : 768), k1 = br == 0 ? 384 : (br == 1 ? 768 : 1024);
            f32x16 acc = {};
            for (int k = k0; k < k1; k += 16) acc = __builtin_amdgcn_mfma_f32_32x32x16_bf16(*(const bf16x8*)(ap + k), *(const bf16x8*)(bp + k), acc, 0, 0, 0);
#pragma unroll
            for (int i = 0; i < 16; ++i) tot[i] += acc[i] * bf2f(GT[(size_t)(tm * 32 + crow(i, h)) * GATEW + br * 1024 + tn * 32 + r]); }
#pragma unroll
        for (int i = 0; i < 16; ++i) MG[(size_t)(tm * 32 + crow(i, h)) * DM + tn * 32 + r] = (bf16)f2bf(tot[i]);
    }
}
__device__ __forceinline__ void p4_out_simple(Frame& F, const Args& A) {
    const bf16* MG = (const bf16*)(F.ws + WS_MERGED); const bf16* WO = (const bf16*)(F.ws + WS_WOUT); float* X1 = (float*)(F.ws + WS_X1); const float* x = A.in[I_X];
    sg_phase(F, NTOK / 32, DM / 32, DM,
        [&](int r) { return MG + (size_t)r * DM; }, [&](int c) { return WO + (size_t)c * DM; },
        [&](int row, int col, float v) { X1[(size_t)row * DM + col] = ALPHA * x[(size_t)row * DM + col] + v; });
}

__device__ __forceinline__ void p5_ln_router(Frame& F, const Args& A) {
    LAS float* WR = (LAS float*)F.lds;
    LAS unsigned* lcnt = (LAS unsigned*)(F.lds + LDS_MISC);
    LAS unsigned* lbase = lcnt + 32;
    LAS unsigned* rinfo = lcnt + 64;
    LAS float* rgate = (LAS float*)(lcnt + 64 + 512);
    const float* WRT = (const float*)(F.ws + WS_WRT);
    for (int i = F.tid; i < 36 * 1024 / 4; i += NTHREADS) ((LAS f32x4*)WR)[i] = ((const f32x4*)WRT)[i];
    float* X1 = (float*)(F.ws + WS_X1); bf16* X1B = (bf16*)(F.ws + WS_X1B);
    int* LIST = (int*)(F.ws + WS_LIST); float* AG = (float*)(F.ws + WS_AGATE);
    unsigned* gcount = F.ctl + CW_GCOUNT;
    const int lane = F.lane;
    f32x4 lg[4], lb[4];
#pragma unroll
    for (int j = 0; j < 4; ++j) { lg[j] = *(const f32x4*)(A.in[I_LN1G] + 4 * lane + 256 * j); lb[j] = *(const f32x4*)(A.in[I_LN1B] + 4 * lane + 256 * j); }
    const float bias_o = lane < 36 ? WRT[36 * 1024 + lane] : 0.f;
    for (int batch = F.bid; batch < NTOK / 128; batch += F.G) {
        __syncthreads();
        if (F.tid < 32) lcnt[F.tid] = 0u;
        __syncthreads();
        for (int g4 = 0; g4 < 4; ++g4) {
            const int lrow0 = F.wave * 16 + g4 * 4, row0 = batch * 128 + lrow0;
            f32x4 v[4][4];
#pragma unroll
            for (int rr = 0; rr < 4; ++rr) {
                float* xr = X1 + (size_t)(row0 + rr) * DM + 4 * lane; float s = 0.f;
#pragma unroll
                for (int j = 0; j < 4; ++j) { v[rr][j] = *(const f32x4*)(xr + 256 * j); s += (v[rr][j].x + v[rr][j].y) + (v[rr][j].z + v[rr][j].w); }
                const float mean = wave_sum(s) * (1.0f / DM); float s2 = 0.f;
#pragma unroll
                for (int j = 0; j < 4; ++j) { v[rr][j] = v[rr][j] - mean; s2 += (v[rr][j].x * v[rr][j].x + v[rr][j].y * v[rr][j].y) + (v[rr][j].z * v[rr][j].z + v[rr][j].w * v[rr][j].w); }
                const float rstd = 1.0f / sqrtf(wave_sum(s2) * (1.0f / DM) + LN_EPS);
                bf16* xb = X1B + (size_t)(row0 + rr) * DM + 4 * lane;
#pragma unroll
                for (int j = 0; j < 4; ++j) { v[rr][j] = v[rr][j] * rstd * lg[j] + lb[j]; *(f32x4*)(xr + 256 * j) = v[rr][j];
                    u32x2 w; w.x = pk2(v[rr][j].x, v[rr][j].y); w.y = pk2(v[rr][j].z, v[rr][j].w); *(u32x2*)(xb + 256 * j) = w; }
            }
            float lo[4] = {0.f, 0.f, 0.f, 0.f};
            for (int o = 0; o < 36; ++o) {
                f32x4 w[4];
#pragma unroll
                for (int j = 0; j < 4; ++j) w[j] = *(const LAS f32x4*)(WR + o * 1024 + 4 * lane + 256 * j);
#pragma unroll
                for (int rr = 0; rr < 4; ++rr) { float p = 0.f;
#pragma unroll
                    for (int j = 0; j < 4; ++j) p += (v[rr][j].x * w[j].x + v[rr][j].y * w[j].y) + (v[rr][j].z * w[j].z + v[rr][j].w * w[j].w);
                    p = wave_sum(p); if (lane == o) lo[rr] = p; }
            }
#pragma unroll
            for (int rr = 0; rr < 4; ++rr) {
                const float lgt = lo[rr] + bias_o;
                const float g0 = __shfl(lgt, 0), g1 = __shfl(lgt, 1), g2 = __shfl(lgt, 2), g3 = __shfl(lgt, 3);
                int gi = 0; float gm = g0; if (g1 > gm) { gm = g1; gi = 1; } if (g2 > gm) { gm = g2; gi = 2; } if (g3 > gm) { gm = g3; gi = 3; }
                const float gden = __expf(g0 - gm) + __expf(g1 - gm) + __expf(g2 - gm) + __expf(g3 - gm);
                const float gp = 1.0f / gden;
                float ev[8];
#pragma unroll
                for (int i = 0; i < 8; ++i) ev[i] = __shfl(lgt, 4 + 8 * gi + i);
                int i1 = 0; float m1 = ev[0];
#pragma unroll
                for (int i = 1; i < 8; ++i) if (ev[i] > m1) { m1 = ev[i]; i1 = i; }
                int i2 = -1; float m2 = -3.0e38f;
#pragma unroll
                for (int i = 0; i < 8; ++i) if (i != i1 && ev[i] > m2) { m2 = ev[i]; i2 = i; }
                const float e2 = __expf(m2 - m1), den = 1.0f + e2;
                const float w1 = gp / den, w2 = gp * e2 / den;
                if (lane == 0) { const int ea = gi * 8 + i1, eb = gi * 8 + i2, lr = lrow0 + rr;
                    const unsigned pa = __hip_atomic_fetch_add(lcnt + ea, 1u, __ATOMIC_RELAXED, __HIP_MEMORY_SCOPE_WORKGROUP), pb = __hip_atomic_fetch_add(lcnt + eb, 1u, __ATOMIC_RELAXED, __HIP_MEMORY_SCOPE_WORKGROUP);
                    rinfo[lr * 4 + 0] = ea; rinfo[lr * 4 + 1] = eb; rinfo[lr * 4 + 2] = pa; rinfo[lr * 4 + 3] = pb; rgate[lr * 2] = w1; rgate[lr * 2 + 1] = w2; }
            }
        }
        __syncthreads();
        if (F.tid < 32) lbase[F.tid] = atomicAdd(gcount + F.tid, lcnt[F.tid]);
        __syncthreads();
        if (F.tid < 128) { const int lr = F.tid, tok = batch * 128 + lr;
            const unsigned ea = rinfo[lr * 4], eb = rinfo[lr * 4 + 1], pa = rinfo[lr * 4 + 2], pb = rinfo[lr * 4 + 3];
            LIST[(size_t)ea * NTOK + lbase[ea] + pa] = 2 * tok; LIST[(size_t)eb * NTOK + lbase[eb] + pb] = 2 * tok + 1;
            AG[2 * tok] = rgate[lr * 2]; AG[2 * tok + 1] = rgate[lr * 2 + 1]; }
    }
    __syncthreads();
}

struct MoeTab { LAS int* tstart; LAS int* cnt; };
__device__ __forceinline__ MoeTab moe_table(Frame& F) {
    MoeTab T; T.tstart = (LAS int*)(F.lds + LDS_MISC + 3072); T.cnt = T.tstart + 40;
    __syncthreads();
    if (F.tid == 0) { int acc = 0; for (int e = 0; e < NEXP; ++e) { const int c = (int)__hip_atomic_load(F.ctl + CW_GCOUNT + e, __ATOMIC_RELAXED, __HIP_MEMORY_SCOPE_AGENT); T.cnt[e] = c; T.tstart[e] = acc; acc += (c + 255) >> 8; } T.tstart[NEXP] = acc; }
    __syncthreads();
    return T;
}
__device__ __forceinline__ int moe_expert_of_tile(const MoeTab& T, int tile) { int e = 0; for (int i = 1; i < NEXP; ++i) if (T.tstart[i] <= tile) e = i; return e; }

__device__ __forceinline__ void p6_moe_up_simple(Frame& F, const Args& A) {
    const MoeTab T = moe_table(F);
    const bf16* X1B = (const bf16*)(F.ws + WS_X1B); const bf16* WGU = (const bf16*)(F.ws + WS_WGU); bf16* H = (bf16*)(F.ws + WS_H); const int* LIST = (const int*)(F.ws + WS_LIST);
    const int gw = F.bid * NWAVES + F.wave, NGW = F.G * NWAVES, r = F.lane & 31, h = F.lane >> 5;
    const int ntile32 = T.tstart[NEXP] * 8;
    for (int w = gw; w < ntile32 * 16; w += NGW) {
        const int t32 = w / 16, cg = w % 16, tile = t32 >> 3, e = moe_expert_of_tile(T, tile), cnt = T.cnt[e];
        int lrow = (tile - T.tstart[e]) * 256 + (t32 & 7) * 32 + r; if (lrow >= cnt) lrow = cnt - 1;
        const int tok = LIST[(size_t)e * NTOK + lrow] >> 1;
        const bf16* ap = X1B + (size_t)tok * DM + 8 * h;
        const int n = cg * 32 + r;
        const bf16* bg = WGU + ((size_t)e * 1024 + (n / 128) * 256 + (n % 128)) * 1024 + 8 * h; const bf16* bu = bg + (size_t)128 * 1024;
        f32x16 ag = {}, au = {};
        for (int k = 0; k < DM; k += 16) { const bf16x8 a = *(const bf16x8*)(ap + k);
            ag = __builtin_amdgcn_mfma_f32_32x32x16_bf16(a, *(const bf16x8*)(bg + k), ag, 0, 0, 0);
            au = __builtin_amdgcn_mfma_f32_32x32x16_bf16(a, *(const bf16x8*)(bu + k), au, 0, 0, 0); }
#pragma unroll
        for (int i = 0; i < 16; ++i) { const float g = ag[i], s = g * __builtin_amdgcn_rcpf(1.0f + fast_exp2(-g * LOG2E));
            H[(size_t)(t32 * 32 + crow(i, h)) * DEXP + n] = (bf16)f2bf(s * au[i]); }
    }
}
__device__ __forceinline__ void p7_moe_down_simple(Frame& F, const Args& A) {
    const MoeTab T = moe_table(F);
    const bf16* H = (const bf16*)(F.ws + WS_H); const bf16* WD = (const bf16*)(F.ws + WS_WD); bf16* Y = (bf16*)(F.ws + WS_Y);
    const int* LIST = (const int*)(F.ws + WS_LIST); const float* AG = (const float*)(F.ws + WS_AGATE);
    const int gw = F.bid * NWAVES + F.wave, NGW = F.G * NWAVES, r = F.lane & 31, h = F.lane >> 5;
    const int ntile32 = T.tstart[NEXP] * 8;
    for (int w = gw; w < ntile32 * 32; w += NGW) {
        const int t32 = w / 32, cg = w % 32, tile = t32 >> 3, e = moe_expert_of_tile(T, tile), cnt = T.cnt[e];
        const bf16* ap = H + (size_t)(t32 * 32 + r) * DEXP + 8 * h;
        const bf16* bp = WD + ((size_t)e * 1024 + cg * 32 + r) * DEXP + 8 * h;
        f32x16 acc = {};
        for (int k = 0; k < DEXP; k += 16) acc = __builtin_amdgcn_mfma_f32_32x32x16_bf16(*(const bf16x8*)(ap + k), *(const bf16x8*)(bp + k), acc, 0, 0, 0);
#pragma unroll
        for (int i = 0; i < 16; ++i) { const int lrow = (tile - T.tstart[e]) * 256 + (t32 & 7) * 32 + crow(i, h);
            if (lrow < cnt) { const int a = LIST[(size_t)e * NTOK + lrow]; Y[(size_t)a * DM + cg * 32 + r] = (bf16)f2bf(acc[i] * AG[a]); } }
    }
}
__device__ __forceinline__ void p8_final(Frame& F, const Args& A) {
    const float* X1 = (const float*)(F.ws + WS_X1); const bf16* Y = (const bf16*)(F.ws + WS_Y);
    const int gw = F.bid * NWAVES + F.wave, NGW = F.G * NWAVES, lane = F.lane;
    f32x4 lg[4], lb[4];
#pragma unroll
    for (int j = 0; j < 4; ++j) { lg[j] = *(const f32x4*)(A.in[I_LN2G] + 4 * lane + 256 * j); lb[j] = *(const f32x4*)(A.in[I_LN2B] + 4 * lane + 256 * j); }
    for (int row = gw; row < NTOK; row += NGW) {
        const float* xr = X1 + (size_t)row * DM + 4 * lane; const bf16* y0 = Y + (size_t)(2 * row) * DM + 4 * lane; const bf16* y1 = y0 + DM;
        f32x4 v[4]; float s = 0.f;
#pragma unroll
        for (int j = 0; j < 4; ++j) { const f32x4 x = *(const f32x4*)(xr + 256 * j); const u32x2 a = *(const u32x2*)(y0 + 256 * j), b = *(const u32x2*)(y1 + 256 * j);
            v[j].x = ALPHA * x.x + (bflo(a.x) + bflo(b.x)); v[j].y = ALPHA * x.y + (bfhi(a.x) + bfhi(b.x)); v[j].z = ALPHA * x.z + (bflo(a.y) + bflo(b.y)); v[j].w = ALPHA * x.w + (bfhi(a.y) + bfhi(b.y));
            s += (v[j].x + v[j].y) + (v[j].z + v[j].w); }
        const float mean = wave_sum(s) * (1.0f / DM); float s2 = 0.f;
#pragma unroll
        for (int j = 0; j < 4; ++j) { v[j] = v[j] - mean; s2 += (v[j].x * v[j].x + v[j].y * v[j].y) + (v[j].z * v[j].z + v[j].w * v[j].w); }
        const float rstd = 1.0f / sqrtf(wave_sum(s2) * (1.0f / DM) + LN_EPS);
        float* orow = F.out + (size_t)row * DM + 4 * lane;
#pragma unroll
        for (int j = 0; j < 4; ++j) *(f32x4*)(orow + 256 * j) = v[j] * rstd * lg[j] + lb[j];
    }
}

constexpr int NPHASE = 10;
__global__ void __launch_bounds__(NTHREADS, 2) fwd(Args args) {
    extern __shared__ __attribute__((aligned(16))) unsigned char lds[];
    Frame F;
    F.lds = (LAS unsigned char*)lds; F.tid = threadIdx.x; F.lane = F.tid & 63; F.wave = __builtin_amdgcn_readfirstlane(F.tid >> 6);
    F.G = gridDim.x; F.bid = blockIdx.x; F.ws = args.ws; F.ctl = (unsigned*)(args.ws + WS_CTL); F.out = args.out;
    for (int u = F.tid; u < (LDS_BYTES - LDS_CTL) / 4; u += NTHREADS) ((LAS unsigned*)(F.lds + LDS_CTL))[u] = 0u;
    __syncthreads();
    XcdBarrier bar; bar.bar = F.ctl + CW_BAR; bar.x = 0; bar.st = nullptr;
    const bool multi = (args.ph_hi - args.ph_lo) > 1;
    if (multi) bar = xcd_barrier_post(F.ctl + CW_BAR, (volatile LAS unsigned*)(F.lds + LDS_CTL));
    const int lo = args.ph_lo, hi = args.ph_hi;
#ifndef PHASE_MASK
#define PHASE_MASK 0xFFFF
#endif
#define IN(k) (((PHASE_MASK >> (k)) & 1) && lo <= (k) && (k) < hi)
#define SEAM(k) do { if (IN(k) && IN((k) + 1)) xcd_barrier(bar); } while (0)
#define LAUNDER() do { asm volatile("" : "+s"(F.ws), "+s"(F.out), "+s"(F.ctl), "+v"(F.tid), "+v"(F.lane)); } while (0)
    if (IN(0)) { LAUNDER(); p0_prologue(F, args); } SEAM(0);
    if (IN(1)) { LAUNDER(); p1_proj_simple(F, args); } SEAM(1);
    if (IN(2)) { LAUNDER(); p1b_kmean(F, args); } SEAM(2);
    if (IN(3)) { LAUNDER(); p2_attn_simple(F, args); } SEAM(3);
    if (IN(4)) { LAUNDER(); convert_experts(F, args); __syncthreads(); p3_merge_simple(F, args); } SEAM(4);
    if (IN(5)) { LAUNDER(); p4_out_simple(F, args); } SEAM(5);
    if (IN(6)) { LAUNDER(); p5_ln_router(F, args); } SEAM(6);
    if (IN(7)) { LAUNDER(); p6_moe_up_simple(F, args); } SEAM(7);
    if (IN(8)) { LAUNDER(); p7_moe_down_simple(F, args); } SEAM(8);
    if (IN(9)) { LAUNDER(); p8_final(F, args); }
#undef IN
#undef SEAM
}

extern "C" void kernel_launch(void* const* d_in, const int* in_sizes, int n_in, void* d_out, int out_size, void* d_ws, size_t ws_size, hipStream_t stream) {
    static int grid = 0;
    if (grid == 0) {
        if (n_in != 20 || in_sizes[0] != NTOK * DM || out_size != NTOK * DM || ws_size < WS_END) { fprintf(stderr, "kernel_launch: unexpected shapes (n_in %d, ws %zu)\n", n_in, ws_size); grid = -1; return; }
        int dev = 0, cus = 0, per_cu = 0;
        if (hipGetDevice(&dev) != hipSuccess || hipDeviceGetAttribute(&cus, hipDeviceAttributeMultiprocessorCount, dev) != hipSuccess) { grid = -1; return; }
        if (hipFuncSetAttribute((const void*)fwd, hipFuncAttributeMaxDynamicSharedMemorySize, LDS_BYTES) != hipSuccess) { fprintf(stderr, "kernel_launch: hipFuncSetAttribute failed\n"); grid = -1; return; }
        if (hipOccupancyMaxActiveBlocksPerMultiprocessor(&per_cu, (const void*)fwd, NTHREADS, LDS_BYTES) != hipSuccess || per_cu < 1) { fprintf(stderr, "kernel_launch: occupancy query says %d\n", per_cu); }
        (void)hipGetLastError();
        grid = cus;
    }
    if (grid < 0) return;
    if (hipMemsetAsync((char*)d_ws + WS_CTL, 0, CTL_ZERO_BYTES, stream) != hipSuccess) return;
    Args a{};
    for (int i = 0; i < 20; ++i) a.in[i] = (const float*)d_in[i];
    a.out = (float*)d_out; a.ws = (unsigned char*)d_ws;
#if N_LAUNCH_PER_PHASE
    for (int p = 0; p < NPHASE; ++p) { a.ph_lo = p; a.ph_hi = p + 1; hipLaunchKernelGGL(fwd, dim3(grid), dim3(NTHREADS), LDS_BYTES, stream, a); }
#else
    a.ph_lo = 0; a.ph_hi = NPHASE; hipLaunchKernelGGL(fwd, dim3(grid), dim3(NTHREADS), LDS_BYTES, stream, a);
#endif
}
```

```cpp
#include <hip/hip_runtime.h>
#include <cstdio>
#include <cstdint>

#ifndef N_LAUNCH_PER_PHASE
#define N_LAUNCH_PER_PHASE 0
#endif
#ifndef FAST_GEMM
#define FAST_GEMM 0
#endif
#ifndef FAST_ATTN
#define FAST_ATTN 0
#endif

#define GAS __attribute__((address_space(1)))
#define LAS __attribute__((address_space(3)))
typedef unsigned short bf16;
typedef short bf16x8 __attribute__((ext_vector_type(8)));
typedef float f32x4 __attribute__((ext_vector_type(4)));
typedef float f32x2 __attribute__((ext_vector_type(2)));
typedef float f32x16 __attribute__((ext_vector_type(16)));
typedef unsigned u32x4 __attribute__((ext_vector_type(4)));
typedef unsigned u32x2 __attribute__((ext_vector_type(2)));

constexpr int BATCH = 8, SEQ = 4096, DM = 1024, NTOK = BATCH * SEQ;
constexpr int HD = 64, NH_A = 6, NH_B = 6, NH_M = 4, NMEM = 256;
constexpr int QKVW = 2560, GATEW = 3072, PROJW = QKVW + GATEW;
constexpr int C_QA = 0, C_KA = 384, C_VA = 768, C_QB = 1152, C_KB = 1536, C_VB = 1920, C_QM = 2304;
constexpr int NBLK = 16;
constexpr int NEXP = 32, DEXP = 512, NGRP = 4, EPG = 8;
constexpr int NASG = NTOK * 2;
constexpr int MAXTILES = NASG / 256 + NEXP;
constexpr float ALPHA = 1.189207115002721f;
constexpr float LN_EPS = 1e-5f;
constexpr float LOG2E = 1.4426950408889634f;
constexpr float C2 = 0.125f * LOG2E;
constexpr float NEGBIG = -1e30f;

constexpr size_t MiB = 1u << 20;
constexpr size_t WS_CTL = 0, CTL_ZERO_BYTES = 1 * MiB;
constexpr size_t WS_KMEAN = 1 * MiB;
constexpr size_t WS_WRT = 1 * MiB + 512 * 1024;
constexpr size_t WS_MEMKV = 2 * MiB;
constexpr size_t WS_MEMB = 4 * MiB;
constexpr size_t WS_LIST = 8 * MiB;
constexpr size_t WS_AGATE = 12 * MiB;
constexpr size_t WS_GATES = 16 * MiB;
constexpr size_t WS_X1 = 16 * MiB;
constexpr size_t WS_X1B = 144 * MiB;
constexpr size_t WS_Y = 144 * MiB;
constexpr size_t WS_QKV = 208 * MiB;
constexpr size_t WS_MERGED = 208 * MiB;
constexpr size_t WS_WGU = 272 * MiB;
constexpr size_t WS_WD = 336 * MiB;
constexpr size_t WS_XB = 368 * MiB;
constexpr size_t WS_YATT = 368 * MiB;
constexpr size_t WS_H = 368 * MiB;
constexpr size_t WS_WIN = 432 * MiB;
constexpr size_t WS_WMKV = 443 * MiB;
constexpr size_t WS_WBR = 444 * MiB;
constexpr size_t WS_WOUT = 446 * MiB;
constexpr size_t WS_END = 448 * MiB;
constexpr int CW_GCOUNT = 64;
constexpr int CW_WQ = 128;
constexpr int CW_BAR = 4096;

constexpr int RING_BYTES = 131072;
constexpr int P5_W_BYTES = 36 * 1024 * 4;
constexpr int LDS_MISC = P5_W_BYTES;
constexpr int LDS_CTL = LDS_MISC + 4096;
constexpr int LDS_BYTES = LDS_CTL + 512;
constexpr int NWAVES = 8, NTHREADS = 512;

__device__ __forceinline__ unsigned f2bf(float f) { unsigned u = __builtin_bit_cast(unsigned, f); return (u + 0x7fffu + ((u >> 16) & 1u)) >> 16; }
__device__ __forceinline__ unsigned pk2(float lo, float hi) { return f2bf(lo) | (f2bf(hi) << 16); }
__device__ __forceinline__ float bf2f(unsigned short b) { return __builtin_bit_cast(float, (unsigned)b << 16); }
__device__ __forceinline__ float bflo(unsigned w) { return __builtin_bit_cast(float, w << 16); }
__device__ __forceinline__ float bfhi(unsigned w) { return __builtin_bit_cast(float, w & 0xffff0000u); }
__device__ __forceinline__ float wave_sum(float v) {
#pragma unroll
    for (int o = 1; o < 64; o <<= 1) v += __shfl_xor(v, o);
    return v;
}
__device__ __forceinline__ float wave_max(float v) {
#pragma unroll
    for (int o = 1; o < 64; o <<= 1) v = fmaxf(v, __shfl_xor(v, o));
    return v;
}
__device__ __forceinline__ float fast_exp2(float x) { return __builtin_amdgcn_exp2f(x); }
__device__ __forceinline__ float fast_log2(float x) { return __builtin_amdgcn_logf(x); }
__device__ __forceinline__ int crow(int r, int hi) { return (r & 3) + 8 * (r >> 2) + 4 * hi; }
__device__ __forceinline__ int t5_bucket(int rel) {
    if (rel < 16) return rel;
    const int l = 16 + (int)(log2f((float)rel * (1.0f / 16.0f)) * (16.0f / 3.0f));
    return l < 31 ? l : 31;
}

#define XB_TMO      128
#define XB_XCNT(j)  (256  + 64 * (j))
#define XB_XSUB(j)  (1280 + 64 * (j))
#define XB_XGEN(j)  (2304 + 64 * (j))
#define XB_TOP      3328
#define XB_TOPGEN   3392
#define XCD_BAR_WORDS 3456
#define XB_SPIN_CAP (1u << 22)
__device__ __forceinline__ unsigned xb_ld(unsigned* p)              { return __hip_atomic_load(p, __ATOMIC_RELAXED, __HIP_MEMORY_SCOPE_AGENT); }
__device__ __forceinline__ unsigned xb_add(unsigned* p, unsigned v) { return __hip_atomic_fetch_add(p, v, __ATOMIC_RELAXED, __HIP_MEMORY_SCOPE_AGENT); }
__device__ __forceinline__ unsigned xb_xcc_id() { return (unsigned)__builtin_amdgcn_s_getreg((3 << 11) | 20) & 0xFu; }
#define XB_SPIN(cond, bar) do { unsigned _sp = 0; while (cond) { __builtin_amdgcn_s_sleep(1); \
    if ((++_sp & 255u) == 0u) { if (xb_ld(&(bar)[XB_TMO])) break; if (_sp > XB_SPIN_CAP) { atomicAdd(&(bar)[XB_TMO], 1u); break; } } } } while (0)
struct XcdBarrier { unsigned* bar; unsigned x; volatile LAS unsigned* st; };
__device__ __forceinline__ XcdBarrier xcd_barrier_post(unsigned* bar, volatile LAS unsigned* st) {
    XcdBarrier b; b.bar = bar; b.x = xb_xcc_id(); b.st = st;
    if (threadIdx.x == 0) (void)xb_add(&bar[XB_XCNT(b.x)], 1u);
    return b;
}
__device__ __forceinline__ void xcd_barrier_complete(unsigned* bar, unsigned x, unsigned& nloc, unsigned& nx) {
    const unsigned G = gridDim.x * gridDim.y * gridDim.z;
    unsigned sum, cnt, mine, sp = 0u;
    for (;;) {
        sum = 0u; cnt = 0u; mine = 0u;
#pragma unroll
        for (unsigned j = 0; j < 16; ++j) { const unsigned c = xb_ld(&bar[XB_XCNT(j)]); sum += c; cnt += (c > 0u) ? 1u : 0u; mine = (j == x) ? c : mine; }
        if (sum == G) break;
        __builtin_amdgcn_s_sleep(1);
        if ((++sp & 255u) == 0u) { if (xb_ld(&bar[XB_TMO])) break; if (sp > XB_SPIN_CAP) { atomicAdd(&bar[XB_TMO], 1u); break; } }
    }
    nloc = mine > 0u ? mine : 1u; nx = cnt > 0u ? cnt : 1u;
}
__device__ __forceinline__ void xcd_barrier(const XcdBarrier& b) {
    asm volatile("s_waitcnt vmcnt(0)" ::: "memory");
    __syncthreads();
    if (threadIdx.x == 0) {
        unsigned* bar = b.bar;
        __builtin_amdgcn_s_waitcnt(0);
        unsigned nloc = b.st[0], nx = b.st[1];
        if (nloc == 0u) { xcd_barrier_complete(bar, b.x, nloc, nx); b.st[0] = nloc; b.st[1] = nx; }
        const unsigned old = xb_add(&bar[XB_XSUB(b.x)], 1u);
        const unsigned gen = old / nloc;
        if (old + 1u == (gen + 1u) * nloc) {
            __builtin_amdgcn_fence(__ATOMIC_RELEASE, "agent");
            asm volatile("s_waitcnt vmcnt(0)" ::: "memory");
            const unsigned og = xb_add(&bar[XB_TOP], 1u);
            const unsigned tg = og / nx;
            if (og + 1u == (tg + 1u) * nx) xb_add(&bar[XB_TOPGEN], 1u);
            else XB_SPIN(xb_ld(&bar[XB_TOPGEN]) == tg, bar);
            __builtin_amdgcn_fence(__ATOMIC_ACQUIRE, "agent");
            xb_add(&bar[XB_XGEN(b.x)], 1u);
            asm volatile("s_waitcnt vmcnt(0)" ::: "memory");
        } else {
            XB_SPIN(xb_ld(&bar[XB_XGEN(b.x)]) == gen, bar);
            __builtin_amdgcn_fence(__ATOMIC_ACQUIRE, "agent");
            asm volatile("s_waitcnt vmcnt(0)" ::: "memory");
        }
    }
    __syncthreads();
}

struct Args { const float* in[20]; float* out; unsigned char* ws; int ph_lo, ph_hi; };
struct Frame {
    LAS unsigned char* lds;
    unsigned* ctl;
    int tid, lane, wave, G, bid;
    unsigned char* ws;
    float* out;
};
enum { I_X = 0, I_MEM, I_WIN, I_WMKV, I_RELB, I_WBA, I_WBB, I_WBM, I_WOUT, I_LN1G, I_LN1B, I_WRG, I_BRG, I_WRE, I_BRE, I_WG, I_WU, I_WD, I_LN2G, I_LN2B };

__device__ __forceinline__ void transpose_item(const float* W, size_t srcN, int k0, int n0, bf16* WT, size_t ldt, size_t drow0, int dcol0, LAS float* scr, int lane) {
#pragma unroll 8
    for (int i = 0; i < 32; ++i) { const int kk = 2 * i + (lane >> 5); scr[kk * 33 + (lane & 31)] = W[(size_t)(k0 + kk) * srcN + n0 + (lane & 31)]; }
    asm volatile("s_waitcnt lgkmcnt(0)" ::: "memory");
    const int c = lane & 7;
#pragma unroll
    for (int j = 0; j < 4; ++j) { const int n = (lane >> 3) + 8 * j; const LAS float* s = scr + (8 * c) * 33 + n;
        u32x4 o; o.x = pk2(s[0 * 33], s[1 * 33]); o.y = pk2(s[2 * 33], s[3 * 33]); o.z = pk2(s[4 * 33], s[5 * 33]); o.w = pk2(s[6 * 33], s[7 * 33]);
        *(u32x4*)(WT + (drow0 + n) * ldt + dcol0 + k0 + 8 * c) = o; }
    asm volatile("s_waitcnt lgkmcnt(0)" ::: "memory");
}
__device__ __forceinline__ void convert_rows_bf16(const float* src, bf16* dst, size_t n_elems, int gthread, int nthreads) {
    const size_t nv = n_elems / 8;
    for (size_t i = gthread; i < nv; i += nthreads) {
        const f32x4 a = *(const f32x4*)(src + i * 8), b = *(const f32x4*)(src + i * 8 + 4);
        u32x4 o; o.x = pk2(a.x, a.y); o.y = pk2(a.z, a.w); o.z = pk2(b.x, b.y); o.w = pk2(b.z, b.w);
        *(u32x4*)(dst + i * 8) = o;
    }
}
__device__ __forceinline__ void p0_prologue(Frame& F, const Args& A) {
    LAS float* scr = (LAS float*)(F.lds + F.wave * 16384);
    const int gw = F.bid * NWAVES + F.wave, NGW = F.G * NWAVES;
    const int gt = F.bid * NTHREADS + F.tid, NGT = F.G * NTHREADS;
    bf16* WIN = (bf16*)(F.ws + WS_WIN); bf16* WMKV = (bf16*)(F.ws + WS_WMKV); bf16* WBR = (bf16*)(F.ws + WS_WBR); bf16* WOUT = (bf16*)(F.ws + WS_WOUT);
    constexpr int I_IN = 16 * (PROJW / 32), I_MK = 16 * (512 / 32), I_BA = 6 * 32, I_BB = 6 * 32, I_BM = 4 * 32, I_WO = 16 * 32;
    constexpr int NITEMS = I_IN + I_MK + I_BA + I_BB + I_BM + I_WO;
    for (int it = gw; it < NITEMS; it += NGW) {
        int r = it;
        if (r < I_IN) { const int nb = PROJW / 32; transpose_item(A.in[I_WIN], PROJW, 64 * (r / nb), 32 * (r % nb), WIN, 1024, 32 * (r % nb), 0, scr, F.lane); continue; } r -= I_IN;
        if (r < I_MK) { const int nb = 16; transpose_item(A.in[I_WMKV], 512, 64 * (r / nb), 32 * (r % nb), WMKV, 1024, 32 * (r % nb), 0, scr, F.lane); continue; } r -= I_MK;
        if (r < I_BA) { const int nb = 32; transpose_item(A.in[I_WBA], 1024, 64 * (r / nb), 32 * (r % nb), WBR, 1024, 32 * (r % nb), 0, scr, F.lane); continue; } r -= I_BA;
        if (r < I_BB) { const int nb = 32; transpose_item(A.in[I_WBB], 1024, 64 * (r / nb), 32 * (r % nb), WBR, 1024, 32 * (r % nb), 384, scr, F.lane); continue; } r -= I_BB;
        if (r < I_BM) { const int nb = 32; transpose_item(A.in[I_WBM], 1024, 64 * (r / nb), 32 * (r % nb), WBR, 1024, 32 * (r % nb), 768, scr, F.lane); continue; } r -= I_BM;
        { const int nb = 32; transpose_item(A.in[I_WOUT], 1024, 64 * (r / nb), 32 * (r % nb), WOUT, 1024, 32 * (r % nb), 0, scr, F.lane); }
    }
    convert_rows_bf16(A.in[I_X], (bf16*)(F.ws + WS_XB), (size_t)NTOK * DM, gt, NGT);
    convert_rows_bf16(A.in[I_MEM], (bf16*)(F.ws + WS_MEMB), (size_t)BATCH * NMEM * DM, gt, NGT);
    float* WRT = (float*)(F.ws + WS_WRT);
    for (int i = gt; i < 36 * 1024; i += NGT) { const int o = i >> 10, k = i & 1023; WRT[i] = o < 4 ? A.in[I_WRG][k * 4 + o] : A.in[I_WRE][k * 32 + (o - 4)]; }
    if (gt < 36) WRT[36 * 1024 + gt] = gt < 4 ? A.in[I_BRG][gt] : A.in[I_BRE][gt - 4];
}
__device__ __forceinline__ void convert_experts(Frame& F, const Args& A) {
    LAS float* scr = (LAS float*)(F.lds + F.wave * 16384);
    const int gw = F.bid * NWAVES + F.wave, NGW = F.G * NWAVES;
    bf16* WGU = (bf16*)(F.ws + WS_WGU); bf16* WD = (bf16*)(F.ws + WS_WD);
    constexpr int PER_GU = 16 * 16;
    constexpr int PER_D = 8 * 32;
    constexpr int NIT = NEXP * (2 * PER_GU + PER_D);
    for (int it = gw; it < NIT; it += NGW) {
        const int e = it / (2 * PER_GU + PER_D); int r = it % (2 * PER_GU + PER_D);
        if (r < 2 * PER_GU) { const int up = r / PER_GU; r %= PER_GU; const int kb = r / 16, nb = r % 16, n0 = 32 * nb;
            const float* src = (up ? A.in[I_WU] : A.in[I_WG]) + (size_t)e * 1024 * 512;
            const size_t drow0 = (size_t)e * 1024 + (n0 / 128) * 256 + up * 128 + (n0 % 128);
            transpose_item(src, 512, 64 * kb, n0, WGU, 1024, drow0, 0, scr, F.lane);
        } else { r -= 2 * PER_GU; const int kb = r / 32, nb = r % 32;
            transpose_item(A.in[I_WD] + (size_t)e * 512 * 1024, 1024, 64 * kb, 32 * nb, WD, 512, (size_t)e * 1024 + 32 * nb, 0, scr, F.lane); }
    }
}

template <class AF, class BF, class EF>
__device__ __forceinline__ void sg_phase(Frame& F, int mt, int nt, int K, AF arow, BF brow, EF epi) {
    const int gw = F.bid * NWAVES + F.wave, NGW = F.G * NWAVES, r = F.lane & 31, h = F.lane >> 5;
    for (int tile = gw; tile < mt * nt; tile += NGW) {
        const int tm = tile / nt, tn = tile % nt;
        const bf16* ap = arow(tm * 32 + r) + 8 * h;
        const bf16* bp = brow(tn * 32 + r) + 8 * h;
        f32x16 acc = {};
        for (int k = 0; k < K; k += 16) {
            const bf16x8 a = *(const bf16x8*)(ap + k), b = *(const bf16x8*)(bp + k);
            acc = __builtin_amdgcn_mfma_f32_32x32x16_bf16(a, b, acc, 0, 0, 0);
        }
#pragma unroll
        for (int i = 0; i < 16; ++i) epi(tm * 32 + crow(i, h), tn * 32 + r, acc[i]);
    }
}

__device__ __forceinline__ float sigmoid_clamped(float v);
__device__ __forceinline__ bool is_qcol(int c);

namespace mg {
constexpr int BM = 256, BK = 64, HALF = 128, HTB = HALF * BK * 2, STAGE_BYTES = 8 * HTB, NXCD = 8, WGM = 8;
__device__ __forceinline__ int lds_byte(int r, int c) { const int st = (r >> 4) * 2 + (c >> 5), rr = r & 15, cc = c & 31, ob = rr * 64 + cc * 2; return st * 1024 + (ob ^ (((ob >> 9) & 1) << 5)); }
__device__ __forceinline__ void stage_rc(int b, int& R, int& C) { const int st = b / 1024, sb = b % 1024, swz = sb ^ (((sb >> 9) & 1) << 5); R = (st >> 1) * 16 + swz / 64; C = (st & 1) * 32 + (swz % 64) / 2; }
__device__ __forceinline__ int perm32(int rho) { const int n = rho >> 4, i = rho & 15; return 8 * (i >> 2) + 4 * n + (i & 3); }
struct Unit { int pm, pn, e, lt; };
__device__ __forceinline__ unsigned cvt_pk_bf16(float lo, float hi) { unsigned r; asm volatile("v_cvt_pk_bf16_f32 %0, %1, %2" : "=v"(r) : "v"(lo), "v"(hi)); return r; }

struct StaticOrder {
    const char* A; const char* Bt; size_t a_tile, b_tile;
    int nM, nN, nwg, G, c;
    __device__ __forceinline__ void init(const void* A_, const void* Bt_, int lda, int ldb, int M, int N, int G_, int c_) { A = (const char*)A_; Bt = (const char*)Bt_; a_tile = (size_t)256 * lda * 2; b_tile = (size_t)256 * ldb * 2; nM = M / BM; nN = N / BM; nwg = nM * nN; G = G_; c = c_; }
    __device__ __forceinline__ bool next(int i, Unit& u) const {
        const long L = (long)i * G + c; if (L >= nwg) return false;
        int wgid = (int)L; { const int q = nwg / NXCD, r = nwg % NXCD, xcd = wgid % NXCD, off = wgid / NXCD; wgid = (xcd < r ? xcd * (q + 1) : r * (q + 1) + (xcd - r) * q) + off; }
        const int nig = WGM * nN, gid = wgid / nig, fm = gid * WGM, gsz = (nM - fm) < WGM ? (nM - fm) : WGM;
        u.pm = fm + ((wgid % nig) % gsz); u.pn = (wgid % nig) / gsz; u.e = 0; u.lt = 0; return true;
    }
    __device__ __forceinline__ const char* a_base(const Unit& u) const { return A + (size_t)u.pm * a_tile; }
    __device__ __forceinline__ const char* b_base(const Unit& u) const { return Bt + (size_t)u.pn * b_tile; }
    __device__ __forceinline__ int row(const Unit&, int) const { return 0; }
};

template <class Epi, class Sched, bool GATHER, bool ALIGN_EPI>
__device__ __forceinline__ void gemm_phase(LAS unsigned char* lds, const int lda, const int ldb, const int K, const Sched& S, const Epi& E) {
    const int tid = threadIdx.x, wid = __builtin_amdgcn_readfirstlane(tid >> 6), lane = tid & 63, wr = wid >> 2, wc = wid & 3, fr = lane & 15, fq = lane >> 4;
    const int nt = K / BK;
    int Rr[2], Cc[2]; unsigned voffB[2], cvA[2][2], nvA[2][2];
#pragma unroll
    for (int i = 0; i < 2; ++i) { stage_rc(tid * 16 + i * 8192, Rr[i], Cc[i]); const int Rb = Epi::PERM ? ((Rr[i] & ~31) + perm32(Rr[i] & 31)) : Rr[i];
        voffB[i] = (unsigned)(Rb * ldb + Cc[i]) * 2u;
#pragma unroll
        for (int h = 0; h < 2; ++h) { cvA[h][i] = (unsigned)((Rr[i] + HALF * h) * lda + Cc[i]) * 2u; nvA[h][i] = cvA[h][i]; } }
    const size_t kstep = (size_t)(BK * 2);
    const size_t hstepB = (size_t)HALF * ldb * 2;
    const unsigned ldsw = (unsigned)wid * 1024u;
    const int aoff = lds_byte(wr * 64 + fr, fq * 8), boff = lds_byte(wc * 32 + fr, fq * 8);
#define MG_SA(b, h) (((b) * 2 + (h)) * mg::HTB)
#define MG_SB(b, h) ((4 + (b) * 2 + (h)) * mg::HTB)
#define MG_STAGE(bufoff, gbase, o0, o1) do { \
        __builtin_amdgcn_global_load_lds((const unsigned*)((const char*)(gbase) + (o0)), (LAS unsigned*)(lds + (bufoff) + ldsw), 16, 0, 0); \
        __builtin_amdgcn_global_load_lds((const unsigned*)((const char*)(gbase) + (o1)), (LAS unsigned*)(lds + (bufoff) + ldsw + 8192), 16, 0, 0); } while (0)
#define MG_LDA(dst, b, h) do { _Pragma("unroll") for (int m = 0; m < 4; ++m) _Pragma("unroll") for (int k = 0; k < 2; ++k) dst[m][k] = *(const LAS bf16x8*)(lds + MG_SA(b, h) + aoff + m * 2048 + k * 1024); } while (0)
#define MG_LDB(dst, b, h) do { _Pragma("unroll") for (int n = 0; n < 2; ++n) _Pragma("unroll") for (int k = 0; k < 2; ++k) dst[n][k] = *(const LAS bf16x8*)(lds + MG_SB(b, h) + boff + n * 2048 + k * 1024); } while (0)
#define MG_MMA(ai, bj, At, Bt) do { __builtin_amdgcn_s_setprio(1); _Pragma("unroll") for (int m = 0; m < 4; ++m) _Pragma("unroll") for (int n = 0; n < 2; ++n) _Pragma("unroll") for (int k = 0; k < 2; ++k) \
        acc[ai][bj][m][n] = __builtin_amdgcn_mfma_f32_16x16x32_bf16(Bt[n][k], At[m][k], acc[ai][bj][m][n], 0, 0, 0); __builtin_amdgcn_s_setprio(0); } while (0)
#define MG_WAIT_V(n) asm volatile("s_waitcnt vmcnt(" #n ")" ::: "memory")
#define MG_WAIT_L(n) asm volatile("s_waitcnt lgkmcnt(" #n ")" ::: "memory")
#define MG_BAR __builtin_amdgcn_s_barrier()
#define MG_SCHED __builtin_amdgcn_sched_barrier(0)
    Unit cur, nxt; int ui = 0;
    if (!S.next(0, cur)) return;
    f32x4 acc[2][2][4][2];
#pragma unroll
    for (int a = 0; a < 2; ++a)
#pragma unroll
        for (int b = 0; b < 2; ++b)
#pragma unroll
            for (int m = 0; m < 4; ++m)
#pragma unroll
                for (int n = 0; n < 2; ++n) acc[a][b][m][n] = (f32x4){0.f, 0.f, 0.f, 0.f};
    bf16x8 At[4][2], B0[2][2], B1[2][2];
    const char* cA = S.a_base(cur); const char* cB = S.b_base(cur);
    if constexpr (GATHER) {
#pragma unroll
        for (int h = 0; h < 2; ++h)
#pragma unroll
            for (int i = 0; i < 2; ++i) cvA[h][i] = (unsigned)S.row(cur, Rr[i] + HALF * h) * (unsigned)(lda * 2) + (unsigned)Cc[i] * 2u;
    }
    MG_STAGE(MG_SB(0, 0), cB, voffB[0], voffB[1]); MG_STAGE(MG_SB(0, 1), cB + hstepB, voffB[0], voffB[1]); MG_STAGE(MG_SA(0, 0), cA, cvA[0][0], cvA[0][1]); MG_STAGE(MG_SA(0, 1), cA, cvA[1][0], cvA[1][1]);
    if (wr == 1) MG_BAR;
    MG_WAIT_V(2); MG_BAR;
    MG_STAGE(MG_SB(1, 0), cB + kstep, voffB[0], voffB[1]); MG_STAGE(MG_SA(1, 0), cA + kstep, cvA[0][0], cvA[0][1]); MG_STAGE(MG_SB(1, 1), cB + hstepB + kstep, voffB[0], voffB[1]);
    MG_WAIT_V(6); MG_BAR;
    for (;;) {
        const bool has_next = S.next(ui + 1, nxt);
        const char* nA = has_next ? S.a_base(nxt) : cA; const char* nB = has_next ? S.b_base(nxt) : cB;
        if constexpr (GATHER) {
#pragma unroll
            for (int h = 0; h < 2; ++h)
#pragma unroll
                for (int i = 0; i < 2; ++i) nvA[h][i] = has_next ? (unsigned)S.row(nxt, Rr[i] + HALF * h) * (unsigned)(lda * 2) + (unsigned)Cc[i] * 2u : cvA[h][i];
        }
        for (int t = 0; t < nt; t += 2) {
            const bool last = (t == nt - 2);
            if constexpr (Epi::HOOK) { if (t == Epi::HK1 || t == Epi::HK2) E.hook(acc, cur, t, wr, wc, fr, fq); }
            const char* a1 = cA + (size_t)(t + 1) * kstep;
            const char* a2 = last ? nA : cA + (size_t)(t + 2) * kstep; const char* b2 = last ? nB : cB + (size_t)(t + 2) * kstep;
            const char* a3 = a2 + kstep; const char* b3 = b2 + kstep;
            unsigned x00 = cvA[0][0], x01 = cvA[0][1], x10 = cvA[1][0], x11 = cvA[1][1];
            if constexpr (GATHER) { if (last) { x00 = nvA[0][0]; x01 = nvA[0][1]; x10 = nvA[1][0]; x11 = nvA[1][1]; } }
            MG_LDB(B0, 0, 0); MG_LDB(B1, 0, 1); MG_SCHED; MG_LDA(At, 0, 0); MG_STAGE(MG_SA(1, 1), a1, cvA[1][0], cvA[1][1]);
            MG_WAIT_V(8); MG_WAIT_L(0); MG_BAR; MG_MMA(0, 0, At, B0); MG_MMA(0, 1, At, B1); MG_BAR; MG_SCHED;
            MG_LDA(At, 0, 1); MG_STAGE(MG_SB(0, 0), b2, voffB[0], voffB[1]); MG_STAGE(MG_SB(0, 1), b2 + hstepB, voffB[0], voffB[1]); MG_STAGE(MG_SA(0, 0), a2, x00, x01);
            MG_WAIT_V(8); MG_WAIT_L(0); MG_BAR; MG_MMA(1, 0, At, B0); MG_MMA(1, 1, At, B1); MG_BAR; MG_SCHED;
            MG_LDB(B0, 1, 0); MG_LDB(B1, 1, 1); MG_SCHED; MG_LDA(At, 1, 0); MG_STAGE(MG_SA(0, 1), a2, x10, x11);
            MG_WAIT_V(8); MG_WAIT_L(0); MG_BAR; MG_MMA(0, 0, At, B0); MG_MMA(0, 1, At, B1); MG_BAR; MG_SCHED;
            MG_LDA(At, 1, 1); MG_STAGE(MG_SB(1, 0), b3, voffB[0], voffB[1]); MG_STAGE(MG_SB(1, 1), b3 + hstepB, voffB[0], voffB[1]); MG_STAGE(MG_SA(1, 0), a3, x00, x01);
            MG_WAIT_V(8); MG_WAIT_L(0); MG_BAR; MG_MMA(1, 0, At, B0); MG_MMA(1, 1, At, B1); MG_BAR; MG_SCHED;
        }
        if constexpr (ALIGN_EPI) { if (wr == 0) MG_BAR; }
        E(acc, cur, wr, wc, fr, fq);
        if (!has_next) break;
#pragma unroll
        for (int a = 0; a < 2; ++a)
#pragma unroll
            for (int b = 0; b < 2; ++b)
#pragma unroll
                for (int m = 0; m < 4; ++m)
#pragma unroll
                    for (int n = 0; n < 2; ++n) acc[a][b][m][n] = (f32x4){0.f, 0.f, 0.f, 0.f};
        cur = nxt; cA = nA; cB = nB; ++ui;
        if constexpr (GATHER) {
#pragma unroll
            for (int h = 0; h < 2; ++h)
#pragma unroll
                for (int i = 0; i < 2; ++i) cvA[h][i] = nvA[h][i];
        }
        if constexpr (ALIGN_EPI) { if (wr == 1) MG_BAR; }
    }
    MG_WAIT_V(0);
    if constexpr (!ALIGN_EPI) { if (wr == 0) MG_BAR; }
    MG_BAR;
#undef MG_SA
#undef MG_SB
#undef MG_STAGE
#undef MG_LDA
#undef MG_LDB
#undef MG_MMA
#undef MG_WAIT_V
#undef MG_WAIT_L
#undef MG_BAR
#undef MG_SCHED
}

typedef f32x4 Acc[2][2][4][2];
struct EpiProj {
    static constexpr bool PERM = true, HOOK = false; static constexpr int HK1 = -1, HK2 = -1;
    bf16* QKV; bf16* GT;
    __device__ __forceinline__ void hook(Acc&, const Unit&, int, int, int, int, int) const {}
    __device__ __forceinline__ void operator()(const Acc& acc, const Unit& u, int wr, int wc, int fr, int fq) const {
        const int row0 = u.pm * BM + wr * 64 + fr, col0 = u.pn * BM + wc * 32 + 8 * fq;
        const bool gate = col0 >= QKVW;
#pragma unroll
        for (int ai = 0; ai < 2; ++ai)
#pragma unroll
            for (int m = 0; m < 4; ++m) { const size_t row = (size_t)(row0 + ai * HALF + m * 16);
#pragma unroll
                for (int bj = 0; bj < 2; ++bj) { const int c = col0 + bj * HALF; f32x4 v0 = acc[ai][bj][m][0], v1 = acc[ai][bj][m][1]; bf16* dst;
                    if (gate) { dst = GT + row * GATEW + (c - QKVW);
#pragma unroll
                        for (int j = 0; j < 4; ++j) { v0[j] = sigmoid_clamped(v0[j]); v1[j] = sigmoid_clamped(v1[j]); } }
                    else { dst = QKV + row * QKVW + c; const float sc = is_qcol(c) ? C2 : 1.0f; v0 = v0 * sc; v1 = v1 * sc; }
                    u32x4 w; w.x = cvt_pk_bf16(v0[0], v0[1]); w.y = cvt_pk_bf16(v0[2], v0[3]); w.z = cvt_pk_bf16(v1[0], v1[1]); w.w = cvt_pk_bf16(v1[2], v1[3]);
                    *(u32x4*)dst = w; } }
    }
};
struct EpiPlainBf16 {
    static constexpr bool PERM = true, HOOK = false; static constexpr int HK1 = -1, HK2 = -1;
    bf16* O; int ldc;
    __device__ __forceinline__ void hook(Acc&, const Unit&, int, int, int, int, int) const {}
    __device__ __forceinline__ void operator()(const Acc& acc, const Unit& u, int wr, int wc, int fr, int fq) const {
        const int row0 = u.pm * BM + wr * 64 + fr, col0 = u.pn * BM + wc * 32 + 8 * fq;
#pragma unroll
        for (int ai = 0; ai < 2; ++ai)
#pragma unroll
            for (int m = 0; m < 4; ++m) { bf16* rowp = O + (size_t)(row0 + ai * HALF + m * 16) * ldc + col0;
#pragma unroll
                for (int bj = 0; bj < 2; ++bj) { const f32x4 v0 = acc[ai][bj][m][0], v1 = acc[ai][bj][m][1];
                    u32x4 w; w.x = cvt_pk_bf16(v0[0], v0[1]); w.y = cvt_pk_bf16(v0[2], v0[3]); w.z = cvt_pk_bf16(v1[0], v1[1]); w.w = cvt_pk_bf16(v1[2], v1[3]);
                    *(u32x4*)(rowp + bj * HALF) = w; } }
    }
};
struct EpiMerge {
    static constexpr bool PERM = true, HOOK = true; static constexpr int HK1 = 6, HK2 = 12;
    const bf16* GT; bf16* MG;
    __device__ __forceinline__ void hook(Acc& acc, const Unit& u, int t, int wr, int wc, int fr, int fq) const {
        int frl = fr, fql = fq; asm volatile("" : "+v"(frl), "+v"(fql));
        const int row0 = u.pm * BM + wr * 64 + frl, col0 = u.pn * BM + wc * 32 + 8 * fql, bp = (t == HK1) ? 0 : 1024;
#pragma unroll
        for (int ai = 0; ai < 2; ++ai)
#pragma unroll
            for (int m = 0; m < 4; ++m) { const bf16* gp = GT + (size_t)(row0 + ai * HALF + m * 16) * GATEW + bp + col0;
#pragma unroll
                for (int bj = 0; bj < 2; ++bj) { const u32x4 a = *(const u32x4*)(gp + bj * HALF), b = *(const u32x4*)(gp + 1024 + bj * HALF);
                    f32x4 r0, r1;
                    r0[0] = bflo(a.x) * __builtin_amdgcn_rcpf(bflo(b.x)); r0[1] = bfhi(a.x) * __builtin_amdgcn_rcpf(bfhi(b.x)); r0[2] = bflo(a.y) * __builtin_amdgcn_rcpf(bflo(b.y)); r0[3] = bfhi(a.y) * __builtin_amdgcn_rcpf(bfhi(b.y));
                    r1[0] = bflo(a.z) * __builtin_amdgcn_rcpf(bflo(b.z)); r1[1] = bfhi(a.z) * __builtin_amdgcn_rcpf(bfhi(b.z)); r1[2] = bflo(a.w) * __builtin_amdgcn_rcpf(bflo(b.w)); r1[3] = bfhi(a.w) * __builtin_amdgcn_rcpf(bfhi(b.w));
                    acc[ai][bj][m][0] = acc[ai][bj][m][0] * r0; acc[ai][bj][m][1] = acc[ai][bj][m][1] * r1; }
                asm volatile("" : "+v"(acc[ai][0][m][0]), "+v"(acc[ai][0][m][1]), "+v"(acc[ai][1][m][0]), "+v"(acc[ai][1][m][1]) :: "memory"); }
    }
    __device__ __forceinline__ void operator()(const Acc& acc, const Unit& u, int wr, int wc, int fr, int fq) const {
        const int row0 = u.pm * BM + wr * 64 + fr, col0 = u.pn * BM + wc * 32 + 8 * fq;
#pragma unroll
        for (int ai = 0; ai < 2; ++ai)
#pragma unroll
            for (int m = 0; m < 4; ++m) { const size_t row = (size_t)(row0 + ai * HALF + m * 16); const bf16* gp = GT + row * GATEW + 2048 + col0;
#pragma unroll
                for (int bj = 0; bj < 2; ++bj) { const u32x4 a = *(const u32x4*)(gp + bj * HALF); const f32x4 v0 = acc[ai][bj][m][0], v1 = acc[ai][bj][m][1];
                    u32x4 w; w.x = cvt_pk_bf16(v0[0] * bflo(a.x), v0[1] * bfhi(a.x)); w.y = cvt_pk_bf16(v0[2] * bflo(a.y), v0[3] * bfhi(a.y));
                    w.z = cvt_pk_bf16(v1[0] * bflo(a.z), v1[1] * bfhi(a.z)); w.w = cvt_pk_bf16(v1[2] * bflo(a.w), v1[3] * bfhi(a.w));
                    *(u32x4*)(MG + row * DM + col0 + bj * HALF) = w; } }
    }
};
struct EpiOut {
    static constexpr bool PERM = false, HOOK = false; static constexpr int HK1 = -1, HK2 = -1;
    const float* X; float* O;
    __device__ __forceinline__ void hook(Acc&, const Unit&, int, int, int, int, int) const {}
    __device__ __forceinline__ void operator()(const Acc& acc, const Unit& u, int wr, int wc, int fr, int fq) const {
        const int row0 = u.pm * BM + wr * 64 + fr, col0 = u.pn * BM + wc * 32 + 4 * fq;
#pragma unroll
        for (int ai = 0; ai < 2; ++ai)
#pragma unroll
            for (int m = 0; m < 4; ++m) { const size_t off = (size_t)(row0 + ai * HALF + m * 16) * DM + col0;
#pragma unroll
                for (int bj = 0; bj < 2; ++bj)
#pragma unroll
                    for (int n = 0; n < 2; ++n) { const f32x4 xv = *(const f32x4*)(X + off + bj * HALF + n * 16); *(f32x4*)(O + off + bj * HALF + n * 16) = xv * ALPHA + acc[ai][bj][m][n]; } }
    }
};
}

__device__ __forceinline__ float sigmoid_clamped(float v) { const float s = __builtin_amdgcn_rcpf(1.0f + fast_exp2(-v * LOG2E)); return fmaxf(s, 1e-18f); }
__device__ __forceinline__ bool is_qcol(int c) { return c < C_KA || (c >= C_QB && c < C_KB) || c >= C_QM; }
__device__ __forceinline__ void p1_proj_simple(Frame& F, const Args& A) {
    const bf16* XB = (const bf16*)(F.ws + WS_XB); const bf16* WIN = (const bf16*)(F.ws + WS_WIN);
    bf16* QKV = (bf16*)(F.ws + WS_QKV); bf16* GT = (bf16*)(F.ws + WS_GATES);
    sg_phase(F, NTOK / 32, PROJW / 32, DM,
        [&](int r) { return XB + (size_t)r * DM; }, [&](int c) { return WIN + (size_t)c * DM; },
        [&](int row, int col, float v) {
            if (col < QKVW) QKV[(size_t)row * QKVW + col] = (bf16)f2bf(is_qcol(col) ? v * C2 : v);
            else GT[(size_t)row * GATEW + (col - QKVW)] = (bf16)f2bf(sigmoid_clamped(v)); });
    const bf16* MB = (const bf16*)(F.ws + WS_MEMB); const bf16* WM = (const bf16*)(F.ws + WS_WMKV); bf16* MKV = (bf16*)(F.ws + WS_MEMKV);
    sg_phase(F, BATCH * NMEM / 32, 512 / 32, DM,
        [&](int r) { return MB + (size_t)r * DM; }, [&](int c) { return WM + (size_t)c * DM; },
        [&](int row, int col, float v) { MKV[(size_t)row * 512 + col] = (bf16)f2bf(v); });
}
__device__ __forceinline__ void p1b_kmean(Frame& F, const Args& A) {
    const bf16* QKV = (const bf16*)(F.ws + WS_QKV); float* KM = (float*)(F.ws + WS_KMEAN);
    for (int u = F.bid; u < BATCH * NBLK; u += F.G) {
        if (F.tid < 384) { const bf16* p = QKV + (size_t)u * 256 * QKVW + C_KA + F.tid; float s = 0.f;
            for (int r = 0; r < 256; ++r) s += bf2f(p[(size_t)r * QKVW]);
            KM[u * 384 + F.tid] = s * (1.0f / 256.0f); }
    }
}

struct RowAcc {
    float m, l; float o[64];
    __device__ __forceinline__ void init() { m = NEGBIG; l = 0.f;
#pragma unroll
        for (int d = 0; d < 64; ++d) o[d] = 0.f; }
    __device__ __forceinline__ void add(float s, const bf16* vrow) {
        if (s > m) { const float f = fast_exp2(m - s); l *= f;
#pragma unroll
            for (int d = 0; d < 64; ++d) o[d] *= f;
            m = s; }
        const float p = fast_exp2(s - m); l += p;
#pragma unroll
        for (int c = 0; c < 8; ++c) { const u32x4 w = *(const u32x4*)(vrow + 8 * c);
            o[8 * c + 0] += p * bflo(w.x); o[8 * c + 1] += p * bfhi(w.x); o[8 * c + 2] += p * bflo(w.y); o[8 * c + 3] += p * bfhi(w.y);
            o[8 * c + 4] += p * bflo(w.z); o[8 * c + 5] += p * bfhi(w.z); o[8 * c + 6] += p * bflo(w.w); o[8 * c + 7] += p * bfhi(w.w); }
    }
    __device__ __forceinline__ void finish(bf16* yrow, int lane) {
        const float M = wave_max(m); const float w = fast_exp2(m - M); const float L = wave_sum(l * w);
        float mine = 0.f;
#pragma unroll
        for (int d = 0; d < 64; ++d) { const float v = wave_sum(o[d] * w); if (lane == d) mine = v; }
        yrow[lane] = (bf16)f2bf(mine / L);
    }
};
__device__ __forceinline__ float dot64(const u32x4 (&q)[8], const bf16* krow) {
    float s = 0.f;
#pragma unroll
    for (int c = 0; c < 8; ++c) { const u32x4 w = *(const u32x4*)(krow + 8 * c);
        s += bflo(q[c].x) * bflo(w.x) + bfhi(q[c].x) * bfhi(w.x) + bflo(q[c].y) * bflo(w.y) + bfhi(q[c].y) * bfhi(w.y)
           + bflo(q[c].z) * bflo(w.z) + bfhi(q[c].z) * bfhi(w.z) + bflo(q[c].w) * bflo(w.w) + bfhi(q[c].w) * bfhi(w.w); }
    return s;
}
__device__ __forceinline__ void p2_attn_simple(Frame& F, const Args& A) {
    const bf16* QKV = (const bf16*)(F.ws + WS_QKV); bf16* Y = (bf16*)(F.ws + WS_YATT);
    const float* KM = (const float*)(F.ws + WS_KMEAN); const bf16* MKV = (const bf16*)(F.ws + WS_MEMKV);
    const float* relb = A.in[I_RELB];
    const int gw = F.bid * NWAVES + F.wave, NGW = F.G * NWAVES, lane = F.lane;
    constexpr int NHALL = NH_A + NH_B + NH_M;
    for (int task = gw; task < NTOK * NHALL; task += NGW) {
        const int hh = task % NHALL, tok = task / NHALL, b = tok / SEQ, t = tok % SEQ;
        u32x4 q[8];
        if (hh < NH_A) {
            const int h = hh, own = t >> 8;
            const bf16* qp = QKV + (size_t)tok * QKVW + C_QA + h * 64;
#pragma unroll
            for (int c = 0; c < 8; ++c) q[c] = *(const u32x4*)(qp + 8 * c);
            float g = NEGBIG;
            if (lane < own) { const float* km = KM + (size_t)(b * NBLK + lane) * 384 + h * 64; g = 0.f;
#pragma unroll
                for (int c = 0; c < 8; ++c) { g += bflo(q[c].x) * km[8 * c] + bfhi(q[c].x) * km[8 * c + 1] + bflo(q[c].y) * km[8 * c + 2] + bfhi(q[c].y) * km[8 * c + 3]
                                                 + bflo(q[c].z) * km[8 * c + 4] + bfhi(q[c].z) * km[8 * c + 5] + bflo(q[c].w) * km[8 * c + 6] + bfhi(q[c].w) * km[8 * c + 7]; } }
            int s1 = -1, s2 = -1, s3 = -1;
#pragma unroll
            for (int r = 0; r < 3; ++r) { if (r < own) { const float mx = wave_max(g); const unsigned long long bal = __ballot(g == mx); const int idx = __ffsll((long long)bal) - 1;
                if (r == 0) s1 = idx; else if (r == 1) s2 = idx; else s3 = idx; if (lane == idx) g = -3.0e38f; } }
            RowAcc A; A.init();
#pragma unroll
            for (int si = 0; si < 4; ++si) { const int blk = si == 0 ? own : (si == 1 ? s1 : (si == 2 ? s2 : s3)); if (blk < 0) continue;
                for (int c = 0; c < 4; ++c) { const int kpos = blk * 256 + c * 64 + lane; const int rel = t - kpos;
                    if (rel < 0) continue;
                    const bf16* kr = QKV + (size_t)(b * SEQ + kpos) * QKVW + C_KA + h * 64;
                    const float s = dot64(q, kr) + relb[t5_bucket(rel) * NH_A + h] * LOG2E;
                    A.add(s, QKV + (size_t)(b * SEQ + kpos) * QKVW + C_VA + h * 64); } }
            A.finish(Y + (size_t)tok * DM + h * 64, lane);
        } else if (hh < NH_A + NH_B) {
            const int h = hh - NH_A;
            const bf16* qp = QKV + (size_t)tok * QKVW + C_QB + h * 64;
#pragma unroll
            for (int c = 0; c < 8; ++c) q[c] = *(const u32x4*)(qp + 8 * c);
            float o[64];
#pragma unroll
            for (int d = 0; d < 64; ++d) o[d] = 0.f;
            float carry = 0.f;
            for (int base = t - 1; base >= 0; base -= 64) {
                const int s = base - lane; const bool valid = s >= 0;
                float z = 0.f, lk = 0.f, sp = 0.f;
                if (valid) { z = dot64(q, QKV + (size_t)(b * SEQ + s) * QKVW + C_KB + h * 64);
                    sp = fmaxf(z, 0.f) + fast_log2(1.0f + fast_exp2(-fabsf(z))); lk = -sp; }
                float pre = lk;
#pragma unroll
                for (int off = 1; off < 64; off <<= 1) { const float v = __shfl_up(pre, off); if (lane >= off) pre += v; }
                const float E = carry + pre - lk;
                if (valid) { const float a = fast_exp2(z - sp + E); const bf16* vr = QKV + (size_t)(b * SEQ + s) * QKVW + C_VB + h * 64;
#pragma unroll
                    for (int c = 0; c < 8; ++c) { const u32x4 w = *(const u32x4*)(vr + 8 * c);
                        o[8 * c + 0] += a * bflo(w.x); o[8 * c + 1] += a * bfhi(w.x); o[8 * c + 2] += a * bflo(w.y); o[8 * c + 3] += a * bfhi(w.y);
                        o[8 * c + 4] += a * bflo(w.z); o[8 * c + 5] += a * bfhi(w.z); o[8 * c + 6] += a * bflo(w.w); o[8 * c + 7] += a * bfhi(w.w); } }
                carry += __shfl(pre, 63);
                if (carry < -150.0f) break;
            }
            float mine = 0.f;
#pragma unroll
            for (int d = 0; d < 64; ++d) { const float v = wave_sum(o[d]); if (lane == d) mine = v; }
            Y[(size_t)tok * DM + 384 + h * 64 + lane] = (bf16)f2bf(mine);
        } else {
            const int h = hh - NH_A - NH_B;
            const bf16* qp = QKV + (size_t)tok * QKVW + C_QM + h * 64;
#pragma unroll
            for (int c = 0; c < 8; ++c) q[c] = *(const u32x4*)(qp + 8 * c);
            RowAcc A; A.init();
            for (int c = 0; c < 4; ++c) { const bf16* kr = MKV + (size_t)(b * NMEM + c * 64 + lane) * 512 + h * 64;
                A.add(dot64(q, kr), kr + 256); }
            A.finish(Y + (size_t)tok * DM + 768 + h * 64, lane);
        }
    }
}


namespace fa {
typedef short s16x4 __attribute__((ext_vector_type(4)));
typedef short v4i16_t __attribute__((ext_vector_type(4)));
typedef const LAS unsigned char* lcp;
__device__ __forceinline__ s16x4 vtr(lcp p) { return __builtin_bit_cast(s16x4, __builtin_amdgcn_ds_read_tr16_b64_v4i16((LAS v4i16_t*)p)); }
#define FA_MFMA(a, b, c) __builtin_amdgcn_mfma_f32_32x32x16_bf16((a), (b), (c), 0, 0, 0)
__device__ __forceinline__ unsigned cvtpk(float lo, float hi) { f32x2 v = {lo, hi}; typedef __bf16 bf2 __attribute__((ext_vector_type(2))); bf2 b = __builtin_convertvector(v, bf2); return __builtin_bit_cast(unsigned, b); }
__device__ __forceinline__ bf16x8 pack8(const f32x16& p, int s8) {
    u32x4 w; w.x = cvtpk(p[s8], p[s8 + 1]); w.y = cvtpk(p[s8 + 2], p[s8 + 3]); w.z = cvtpk(p[s8 + 4], p[s8 + 5]); w.w = cvtpk(p[s8 + 6], p[s8 + 7]); return __builtin_bit_cast(bf16x8, w); }
__device__ __forceinline__ float max16(const f32x16& p) { float a = fmaxf(fmaxf(p[0], p[1]), fmaxf(p[2], p[3])), b = fmaxf(fmaxf(p[4], p[5]), fmaxf(p[6], p[7]));
    float c = fmaxf(fmaxf(p[8], p[9]), fmaxf(p[10], p[11])), d = fmaxf(fmaxf(p[12], p[13]), fmaxf(p[14], p[15])); return fmaxf(fmaxf(a, b), fmaxf(c, d)); }
__device__ __forceinline__ float sum16(const f32x16& p) { return ((p[0] + p[1]) + (p[2] + p[3])) + ((p[4] + p[5]) + (p[6] + p[7])) + (((p[8] + p[9]) + (p[10] + p[11])) + ((p[12] + p[13]) + (p[14] + p[15]))); }

constexpr int L_K = 0, L_V = 16384, L_WS = 32768, L_TBL = 34816, L_KM = 35328, L_END = 39424;
constexpr float THR = 8.0f;

template <bool MEM>
__device__ __forceinline__ void softmax_unit(Frame& F, const Args& A, int b, int h, int qb) {
    const int tid = F.tid, lane = F.lane, r32 = lane & 31, hi = lane >> 5, wid = F.wave;
    LAS unsigned char* L = F.lds;
    const bf16* QKV = (const bf16*)(F.ws + WS_QKV) + (size_t)b * SEQ * QKVW;
    const bf16* Qp = QKV + (MEM ? C_QM : C_QA) + h * 64;
    const int kvp = MEM ? 512 : QKVW;
    const bf16* Kp = MEM ? (const bf16*)(F.ws + WS_MEMKV) + (size_t)b * NMEM * 512 + h * 64 : QKV + C_KA + h * 64;
    const bf16* Vp = MEM ? Kp + 256 : QKV + C_VA + h * 64;
    const int q0 = qb * 256, qw0 = q0 + wid * 32, qpos = qw0 + r32, own = qb;
    bf16x8 qr[4];
#pragma unroll
    for (int d0 = 0; d0 < 4; ++d0) qr[d0] = *(const bf16x8*)(Qp + (size_t)qpos * QKVW + d0 * 16 + hi * 8);
    LAS float* wsf = (LAS float*)(L + L_WS) + wid * 64;
    LAS float* tbl = (LAS float*)(L + L_TBL);
    LAS float* km = (LAS float*)(L + L_KM);
    const bf16* ksrc = Kp + (size_t)lane * kvp + wid * 8;
    const bf16* vsrc = Vp + (size_t)(16 * (wid & 3) + (lane >> 2)) * kvp + (wid >> 2) * 32 + (lane & 3) * 8;
#define FA_DMA(k0_, slot_) do { \
        __builtin_amdgcn_global_load_lds((const unsigned*)(ksrc + (size_t)(k0_) * kvp), (LAS unsigned*)(L + L_K + (slot_) * 8192 + wid * 1024), 16, 0, 0); \
        __builtin_amdgcn_global_load_lds((const unsigned*)(vsrc + (size_t)(k0_) * kvp), (LAS unsigned*)(L + L_V + (slot_) * 8192 + wid * 1024), 16, 0, 0); } while (0)
    const int NT = MEM ? 4 : 4 * (own + 1);
#define FA_K0(t_) (MEM ? 64 * (t_) : ((t_) < 4 ? own * 256 + 64 * (t_) : (own - 1 - (((t_) - 4) >> 2)) * 256 + 64 * (((t_) - 4) & 3)))
    unsigned selmask = 0u; float bias31 = 0.f;
    if constexpr (!MEM) {
        if (tid < 128) tbl[tid] = A.in[I_RELB][t5_bucket(tid) * NH_A + h] * LOG2E;
        const float* KM = (const float*)(F.ws + WS_KMEAN) + (size_t)(b * NBLK) * 384 + h * 64;
        for (int i = tid; i < own * 64; i += NTHREADS) km[i] = KM[(size_t)(i >> 6) * 384 + (i & 63)];
    }
    FA_DMA(FA_K0(0), 0);
    if constexpr (!MEM) {
        __syncthreads();
        bias31 = tbl[127];
        float qf[32];
#pragma unroll
        for (int d0 = 0; d0 < 4; ++d0) { const u32x4 w = __builtin_bit_cast(u32x4, qr[d0]);
            qf[8 * d0 + 0] = bflo(w.x); qf[8 * d0 + 1] = bfhi(w.x); qf[8 * d0 + 2] = bflo(w.y); qf[8 * d0 + 3] = bfhi(w.y); qf[8 * d0 + 4] = bflo(w.z); qf[8 * d0 + 5] = bfhi(w.z); qf[8 * d0 + 6] = bflo(w.w); qf[8 * d0 + 7] = bfhi(w.w); }
        float g[15];
#pragma unroll
        for (int j = 0; j < 15; ++j) { g[j] = NEGBIG;
            if (j < own) { float sacc = 0.f;
#pragma unroll
                for (int d0 = 0; d0 < 4; ++d0) { const f32x4 k0v = *(const LAS f32x4*)(km + j * 64 + d0 * 16 + hi * 8), k1v = *(const LAS f32x4*)(km + j * 64 + d0 * 16 + hi * 8 + 4);
                    sacc += (qf[8 * d0] * k0v.x + qf[8 * d0 + 1] * k0v.y) + (qf[8 * d0 + 2] * k0v.z + qf[8 * d0 + 3] * k0v.w) + (qf[8 * d0 + 4] * k1v.x + qf[8 * d0 + 5] * k1v.y) + (qf[8 * d0 + 6] * k1v.z + qf[8 * d0 + 7] * k1v.w); }
                g[j] = sacc + __shfl_xor(sacc, 32); } }
        if (own <= 3) selmask = (1u << own) - 1u;
        else {
#pragma unroll
            for (int r = 0; r < 3; ++r) { float best = -3.0e38f; int bi = 0;
#pragma unroll
                for (int j = 0; j < 15; ++j) { const bool c = (j < own) && !((selmask >> j) & 1u) && (g[j] > best); best = c ? g[j] : best; bi = c ? j : bi; }
                selmask |= 1u << bi; }
        }
    }
    float m = NEGBIG, l = 0.f;
    f32x16 o[2]; o[0] = f32x16{}; o[1] = f32x16{};
    const lcp kp0 = (lcp)L + L_K + hi * 1024 + r32 * 16;
    const lcp vp0 = (lcp)L + L_V + ((lane >> 4) & 1) * 32 + (lane & 3) * 8 + (4 * hi + ((lane & 15) >> 2)) * 64;
    for (int t = 0; t < NT; ++t) {
        asm volatile("s_waitcnt vmcnt(0)" ::: "memory");
        __syncthreads();
        if (t + 1 < NT) FA_DMA(FA_K0(t + 1), (t + 1) & 1);
        const int k0 = FA_K0(t), blk = MEM ? 0 : (k0 >> 8);
        if (!MEM && blk == own && k0 > qw0 + 31) continue;
        const lcp kp = kp0 + (t & 1) * 8192; const lcp vp = vp0 + (t & 1) * 8192;
        f32x16 p0 = f32x16{}, p1 = f32x16{};
#pragma unroll
        for (int d0 = 0; d0 < 4; ++d0) { const bf16x8 ka = *(const LAS bf16x8*)(kp + d0 * 2048), kb = *(const LAS bf16x8*)(kp + d0 * 2048 + 512);
            p0 = FA_MFMA(ka, qr[d0], p0); p1 = FA_MFMA(kb, qr[d0], p1); }
        if constexpr (!MEM) {
            const bool sel = (blk == own) || ((selmask >> blk) & 1u);
            if (qw0 - (k0 + 63) < 113) {
#pragma unroll
                for (int i = 0; i < 16; ++i) { const int rel0 = qpos - (k0 + crow(i, hi)), rel1 = rel0 - 32;
                    const float b0 = tbl[rel0 < 0 ? 0 : (rel0 > 127 ? 127 : rel0)], b1 = tbl[rel1 < 0 ? 0 : (rel1 > 127 ? 127 : rel1)];
                    p0[i] = (sel && rel0 >= 0) ? p0[i] + b0 : NEGBIG; p1[i] = (sel && rel1 >= 0) ? p1[i] + b1 : NEGBIG; }
            } else { const float pen = sel ? bias31 : NEGBIG;
#pragma unroll
                for (int i = 0; i < 16; ++i) { p0[i] = sel ? p0[i] + pen : NEGBIG; p1[i] = sel ? p1[i] + pen : NEGBIG; } }
        }
        float rm = fmaxf(max16(p0), max16(p1)); rm = fmaxf(rm, __shfl_xor(rm, 32));
        if (__any(rm > m + THR)) {
            const float mn = fmaxf(m, rm), al = fast_exp2(m - mn); l *= al; m = mn;
            if (hi == 0) wsf[r32] = al;
            asm volatile("s_waitcnt lgkmcnt(0)" ::: "memory");
#pragma unroll
            for (int i = 0; i < 16; ++i) { const float a_ = wsf[crow(i, hi)]; o[0][i] *= a_; o[1][i] *= a_; }
        }
#pragma unroll
        for (int i = 0; i < 16; ++i) { p0[i] = fast_exp2(p0[i] - m); p1[i] = fast_exp2(p1[i] - m); }
        l += sum16(p0) + sum16(p1);
        const bf16x8 pa0 = pack8(p0, 0), pa1 = pack8(p0, 8), pa2 = pack8(p1, 0), pa3 = pack8(p1, 8);
#pragma unroll
        for (int d0 = 0; d0 < 2; ++d0) {
            s16x4 lo[4], hh[4];
#pragma unroll
            for (int ks = 0; ks < 4; ++ks) { lo[ks] = vtr(vp + d0 * 4096 + ks * 1024); hh[ks] = vtr(vp + d0 * 4096 + ks * 1024 + 512); }
#define FA_VF(k) (bf16x8){lo[k][0], lo[k][1], lo[k][2], lo[k][3], hh[k][0], hh[k][1], hh[k][2], hh[k][3]}
            o[d0] = FA_MFMA(pa0, FA_VF(0), o[d0]); o[d0] = FA_MFMA(pa1, FA_VF(1), o[d0]); o[d0] = FA_MFMA(pa2, FA_VF(2), o[d0]); o[d0] = FA_MFMA(pa3, FA_VF(3), o[d0]);
        }
    }
    l += __shfl_xor(l, 32);
    if (hi == 0) wsf[r32] = 1.0f / l;
    asm volatile("s_waitcnt lgkmcnt(0)" ::: "memory");
    bf16* Y = (bf16*)(F.ws + WS_YATT) + (size_t)(b * SEQ + qw0) * DM + (MEM ? 768 : 0) + h * 64 + r32;
#pragma unroll
    for (int i = 0; i < 16; ++i) { const float inv = wsf[crow(i, hi)]; bf16* yr = Y + (size_t)crow(i, hi) * DM;
        yr[0] = (bf16)f2bf(o[0][i] * inv); yr[32] = (bf16)f2bf(o[1][i] * inv); }
#undef FA_DMA
#undef FA_K0
}

__device__ __forceinline__ void sb_unit(Frame& F, const Args& A, int b, int h, int qb) {
    const int lane = F.lane, r32 = lane & 31, hi = lane >> 5, wid = F.wave;
    LAS unsigned char* L = F.lds + wid * 16384;
    const bf16* QKV = (const bf16*)(F.ws + WS_QKV) + (size_t)b * SEQ * QKVW;
    const bf16* Qp = QKV + C_QB + h * 64; const bf16* Kp = QKV + C_KB + h * 64; const bf16* Vp = QKV + C_VB + h * 64;
    const int qw0 = qb * 256 + wid * 32, qpos = qw0 + r32;
    bf16x8 qr[4];
#pragma unroll
    for (int d0 = 0; d0 < 4; ++d0) qr[d0] = *(const bf16x8*)(Qp + (size_t)qpos * QKVW + d0 * 16 + hi * 8);
    const bf16* kbase = Kp + (size_t)r32 * QKVW + hi * 8;
    const bf16* vsrc = Vp + (size_t)(lane >> 2) * QKVW + (lane & 3) * 8;
    const lcp vp0 = (lcp)L + ((lane >> 4) & 1) * 32 + (lane & 3) * 8 + (4 * hi + ((lane & 15) >> 2)) * 64;
    bf16x8 kf[8];
#define SB_LOADK(k0_) do { _Pragma("unroll") for (int d0 = 0; d0 < 4; ++d0) { kf[2 * d0] = *(const bf16x8*)(kbase + (size_t)(k0_) * QKVW + d0 * 16); kf[2 * d0 + 1] = *(const bf16x8*)(kbase + (size_t)((k0_) + 32) * QKVW + d0 * 16); } } while (0)
#define SB_DMAV(k0_, slot_) do { _Pragma("unroll") for (int w = 0; w < 8; ++w) \
        __builtin_amdgcn_global_load_lds((const unsigned*)(vsrc + (size_t)((k0_) + 16 * (w & 3)) * QKVW + (w >> 2) * 32), (LAS unsigned*)(L + (slot_) * 8192 + w * 1024), 16, 0, 0); } while (0)
    int k0 = (qw0 >> 6) << 6, slot = 0; bool first = true;
    SB_LOADK(k0); SB_DMAV(k0, 0);
    float carry = 0.f;
    f32x16 o[2]; o[0] = f32x16{}; o[1] = f32x16{};
    for (;;) {
        asm volatile("s_waitcnt vmcnt(0)" ::: "memory");
        f32x16 p0 = f32x16{}, p1 = f32x16{};
#pragma unroll
        for (int d0 = 0; d0 < 4; ++d0) { p0 = FA_MFMA(kf[2 * d0], qr[d0], p0); p1 = FA_MFMA(kf[2 * d0 + 1], qr[d0], p1); }
        const int k0n = k0 - 64;
        if (k0n >= 0) { SB_LOADK(k0n); SB_DMAV(k0n, slot ^ 1); }
        f32x16 lk0, lk1;
#pragma unroll
        for (int i = 0; i < 16; ++i) {
            const float z0 = p0[i], z1 = p1[i];
            const float sp0 = fmaxf(z0, 0.f) + fast_log2(1.0f + fast_exp2(-fabsf(z0))), sp1 = fmaxf(z1, 0.f) + fast_log2(1.0f + fast_exp2(-fabsf(z1)));
            const bool v0 = !first || (k0 + crow(i, hi) < qpos), v1 = !first || (k0 + 32 + crow(i, hi) < qpos);
            lk0[i] = v0 ? -sp0 : 0.f; lk1[i] = v1 ? -sp1 : 0.f;
            p0[i] = v0 ? z0 - sp0 : NEGBIG; p1[i] = v1 ? z1 - sp1 : NEGBIG;
        }
        float gs[8], pg[8], T[8];
#pragma unroll
        for (int q = 0; q < 4; ++q) { gs[q] = (lk0[4 * q] + lk0[4 * q + 1]) + (lk0[4 * q + 2] + lk0[4 * q + 3]); gs[4 + q] = (lk1[4 * q] + lk1[4 * q + 1]) + (lk1[4 * q + 2] + lk1[4 * q + 3]); }
#pragma unroll
        for (int e = 0; e < 8; ++e) pg[e] = __shfl_xor(gs[e], 32);
        T[7] = 0.f;
#pragma unroll
        for (int e = 6; e >= 0; --e) T[e] = T[e + 1] + (gs[e + 1] + pg[e + 1]);
        const float total = T[0] + (gs[0] + pg[0]);
#pragma unroll
        for (int e = 0; e < 8; ++e) {
            const float base = carry + T[e] + (hi == 0 ? pg[e] : 0.f);
            if (e < 4) { const int q = e; const float e3 = base, e2 = e3 + lk0[4 * q + 3], e1 = e2 + lk0[4 * q + 2], e0 = e1 + lk0[4 * q + 1];
                p0[4 * q] = fast_exp2(p0[4 * q] + e0); p0[4 * q + 1] = fast_exp2(p0[4 * q + 1] + e1); p0[4 * q + 2] = fast_exp2(p0[4 * q + 2] + e2); p0[4 * q + 3] = fast_exp2(p0[4 * q + 3] + e3); }
            else { const int q = e - 4; const float e3 = base, e2 = e3 + lk1[4 * q + 3], e1 = e2 + lk1[4 * q + 2], e0 = e1 + lk1[4 * q + 1];
                p1[4 * q] = fast_exp2(p1[4 * q] + e0); p1[4 * q + 1] = fast_exp2(p1[4 * q + 1] + e1); p1[4 * q + 2] = fast_exp2(p1[4 * q + 2] + e2); p1[4 * q + 3] = fast_exp2(p1[4 * q + 3] + e3); }
        }
        carry += total;
        const bf16x8 pa0 = pack8(p0, 0), pa1 = pack8(p0, 8), pa2 = pack8(p1, 0), pa3 = pack8(p1, 8);
        const lcp vp = vp0 + slot * 8192;
#pragma unroll
        for (int d0 = 0; d0 < 2; ++d0) {
            s16x4 lo[4], hh[4];
#pragma unroll
            for (int ks = 0; ks < 4; ++ks) { lo[ks] = vtr(vp + d0 * 4096 + ks * 1024); hh[ks] = vtr(vp + d0 * 4096 + ks * 1024 + 512); }
            o[d0] = FA_MFMA(pa0, FA_VF(0), o[d0]); o[d0] = FA_MFMA(pa1, FA_VF(1), o[d0]); o[d0] = FA_MFMA(pa2, FA_VF(2), o[d0]); o[d0] = FA_MFMA(pa3, FA_VF(3), o[d0]);
        }
        if (k0n < 0 || __all(carry < -150.0f)) break;
        k0 = k0n; slot ^= 1; first = false;
    }
    asm volatile("s_waitcnt vmcnt(0)" ::: "memory");
    bf16* Y = (bf16*)(F.ws + WS_YATT) + (size_t)(b * SEQ + qw0) * DM + 384 + h * 64 + r32;
#pragma unroll
    for (int i = 0; i < 16; ++i) { bf16* yr = Y + (size_t)crow(i, hi) * DM; yr[0] = (bf16)f2bf(o[0][i]); yr[32] = (bf16)f2bf(o[1][i]); }
#undef SB_LOADK
#undef SB_DMAV
#undef FA_VF
}
__device__ __forceinline__ int wq_pop(Frame& F, unsigned* ctr) {
    LAS int* slot = (LAS int*)(F.lds + LDS_MISC + 2048);
    __syncthreads();
    if (F.tid == 0) *slot = (int)__hip_atomic_fetch_add(ctr, 1u, __ATOMIC_RELAXED, __HIP_MEMORY_SCOPE_AGENT);
    __syncthreads();
    return __builtin_amdgcn_readfirstlane(*slot);
}
}
__device__ __forceinline__ void p2_attn_fast(Frame& F, const Args& A) {
    for (;;) { const int u = fa::wq_pop(F, F.ctl + CW_WQ); if (u >= BATCH * NH_A * NBLK) break;
        const int qb = 15 - u / (BATCH * NH_A), bh = u % (BATCH * NH_A); fa::softmax_unit<false>(F, A, bh / NH_A, bh % NH_A, qb); }
    for (;;) { const int u = fa::wq_pop(F, F.ctl + CW_WQ + 64); if (u >= BATCH * NH_M * NBLK) break;
        const int qb = u / (BATCH * NH_M), bh = u % (BATCH * NH_M); fa::softmax_unit<true>(F, A, bh / NH_M, bh % NH_M, qb); }
    for (;;) { const int u = fa::wq_pop(F, F.ctl + CW_WQ + 128); if (u >= BATCH * NH_B * NBLK) break;
        const int qb = u / (BATCH * NH_B), bh = u % (BATCH * NH_B); fa::sb_unit(F, A, bh / NH_B, bh % NH_B, qb); }
}

__device__ __forceinline__ void p3_merge_simple(Frame& F, const Args& A) {
    const bf16* YA = (const bf16*)(F.ws + WS_YATT); const bf16* WBR = (const bf16*)(F.ws + WS_WBR); const bf16* GT = (const bf16*)(F.ws + WS_GATES);
    bf16* MG = (bf16*)(F.ws + WS_MERGED);
    const int gw = F.bid * NWAVES + F.wave, NGW = F.G * NWAVES, r = F.lane & 31, h = F.lane >> 5;
    for (int tile = gw; tile < (NTOK / 32) * (DM / 32); tile += NGW) {
        const int tm = tile / 32, tn = tile % 32;
        const bf16* ap = YA + (size_t)(tm * 32 + r) * DM + 8 * h; const bf16* bp = WBR + (size_t)(tn * 32 + r) * DM + 8 * h;
        f32x16 tot = {};
#pragma unroll 1
        for (int br = 0; br < 3; ++br) { const int k0 = br == 0 ? 0 : (br == 1 ? 384 : 768), k1 = br == 0 ? 384 : (br == 1 ? 768 : 1024);
            f32x16 acc = {};
            for (int k = k0; k < k1; k += 16) acc = __builtin_amdgcn_mfma_f32_32x32x16_bf16(*(const bf16x8*)(ap + k), *(const bf16x8*)(bp + k), acc, 0, 0, 0);
#pragma unroll
            for (int i = 0; i < 16; ++i) tot[i] += acc[i] * bf2f(GT[(size_t)(tm * 32 + crow(i, h)) * GATEW + br * 1024 + tn * 32 + r]); }
#pragma unroll
        for (int i = 0; i < 16; ++i) MG[(size_t)(tm * 32 + crow(i, h)) * DM + tn * 32 + r] = (bf16)f2bf(tot[i]);
    }
}
__device__ __forceinline__ void p4_out_simple(Frame& F, const Args& A) {
    const bf16* MG = (const bf16*)(F.ws + WS_MERGED); const bf16* WO = (const bf16*)(F.ws + WS_WOUT); float* X1 = (float*)(F.ws + WS_X1); const float* x = A.in[I_X];
    sg_phase(F, NTOK / 32, DM / 32, DM,
        [&](int r) { return MG + (size_t)r * DM; }, [&](int c) { return WO + (size_t)c * DM; },
        [&](int row, int col, float v) { X1[(size_t)row * DM + col] = ALPHA * x[(size_t)row * DM + col] + v; });
}

__device__ __forceinline__ void p5_ln_router(Frame& F, const Args& A) {
    LAS float* WR = (LAS float*)F.lds;
    LAS unsigned* lcnt = (LAS unsigned*)(F.lds + LDS_MISC);
    LAS unsigned* lbase = lcnt + 32;
    LAS unsigned* rinfo = lcnt + 64;
    LAS float* rgate = (LAS float*)(lcnt + 64 + 512);
    const float* WRT = (const float*)(F.ws + WS_WRT);
    for (int i = F.tid; i < 36 * 1024 / 4; i += NTHREADS) ((LAS f32x4*)WR)[i] = ((const f32x4*)WRT)[i];
    float* X1 = (float*)(F.ws + WS_X1); bf16* X1B = (bf16*)(F.ws + WS_X1B);
    int* LIST = (int*)(F.ws + WS_LIST); float* AG = (float*)(F.ws + WS_AGATE);
    unsigned* gcount = F.ctl + CW_GCOUNT;
    const int lane = F.lane;
    f32x4 lg[4], lb[4];
#pragma unroll
    for (int j = 0; j < 4; ++j) { lg[j] = *(const f32x4*)(A.in[I_LN1G] + 4 * lane + 256 * j); lb[j] = *(const f32x4*)(A.in[I_LN1B] + 4 * lane + 256 * j); }
    const float bias_o = lane < 36 ? WRT[36 * 1024 + lane] : 0.f;
    for (int batch = F.bid; batch < NTOK / 128; batch += F.G) {
        __syncthreads();
        if (F.tid < 32) lcnt[F.tid] = 0u;
        __syncthreads();
        for (int g4 = 0; g4 < 4; ++g4) {
            const int lrow0 = F.wave * 16 + g4 * 4, row0 = batch * 128 + lrow0;
            f32x4 v[4][4];
#pragma unroll
            for (int rr = 0; rr < 4; ++rr) {
                float* xr = X1 + (size_t)(row0 + rr) * DM + 4 * lane; float s = 0.f;
#pragma unroll
                for (int j = 0; j < 4; ++j) { v[rr][j] = *(const f32x4*)(xr + 256 * j); s += (v[rr][j].x + v[rr][j].y) + (v[rr][j].z + v[rr][j].w); }
                const float mean = wave_sum(s) * (1.0f / DM); float s2 = 0.f;
#pragma unroll
                for (int j = 0; j < 4; ++j) { v[rr][j] = v[rr][j] - mean; s2 += (v[rr][j].x * v[rr][j].x + v[rr][j].y * v[rr][j].y) + (v[rr][j].z * v[rr][j].z + v[rr][j].w * v[rr][j].w); }
                const float rstd = 1.0f / sqrtf(wave_sum(s2) * (1.0f / DM) + LN_EPS);
                bf16* xb = X1B + (size_t)(row0 + rr) * DM + 4 * lane;
#pragma unroll
                for (int j = 0; j < 4; ++j) { v[rr][j] = v[rr][j] * rstd * lg[j] + lb[j]; *(f32x4*)(xr + 256 * j) = v[rr][j];
                    u32x2 w; w.x = pk2(v[rr][j].x, v[rr][j].y); w.y = pk2(v[rr][j].z, v[rr][j].w); *(u32x2*)(xb + 256 * j) = w; }
            }
            float lo[4] = {0.f, 0.f, 0.f, 0.f};
            for (int o = 0; o < 36; ++o) {
                f32x4 w[4];
#pragma unroll
                for (int j = 0; j < 4; ++j) w[j] = *(const LAS f32x4*)(WR + o * 1024 + 4 * lane + 256 * j);
#pragma unroll
                for (int rr = 0; rr < 4; ++rr) { float p = 0.f;
#pragma unroll
                    for (int j = 0; j < 4; ++j) p += (v[rr][j].x * w[j].x + v[rr][j].y * w[j].y) + (v[rr][j].z * w[j].z + v[rr][j].w * w[j].w);
                    p = wave_sum(p); if (lane == o) lo[rr] = p; }
            }
#pragma unroll
            for (int rr = 0; rr < 4; ++rr) {
                const float lgt = lo[rr] + bias_o;
                const float g0 = __shfl(lgt, 0), g1 = __shfl(lgt, 1), g2 = __shfl(lgt, 2), g3 = __shfl(lgt, 3);
                int gi = 0; float gm = g0; if (g1 > gm) { gm = g1; gi = 1; } if (g2 > gm) { gm = g2; gi = 2; } if (g3 > gm) { gm = g3; gi = 3; }
                const float gden = __expf(g0 - gm) + __expf(g1 - gm) + __expf(g2 - gm) + __expf(g3 - gm);
                const float gp = 1.0f / gden;
                float ev[8];
#pragma unroll
                for (int i = 0; i < 8; ++i) ev[i] = __shfl(lgt, 4 + 8 * gi + i);
                int i1 = 0; float m1 = ev[0];
#pragma unroll
                for (int i = 1; i < 8; ++i) if (ev[i] > m1) { m1 = ev[i]; i1 = i; }
                int i2 = -1; float m2 = -3.0e38f;
#pragma unroll
                for (int i = 0; i < 8; ++i) if (i != i1 && ev[i] > m2) { m2 = ev[i]; i2 = i; }
                const float e2 = __expf(m2 - m1), den = 1.0f + e2;
                const float w1 = gp / den, w2 = gp * e2 / den;
                if (lane == 0) { const int ea = gi * 8 + i1, eb = gi * 8 + i2, lr = lrow0 + rr;
                    const unsigned pa = __hip_atomic_fetch_add(lcnt + ea, 1u, __ATOMIC_RELAXED, __HIP_MEMORY_SCOPE_WORKGROUP), pb = __hip_atomic_fetch_add(lcnt + eb, 1u, __ATOMIC_RELAXED, __HIP_MEMORY_SCOPE_WORKGROUP);
                    rinfo[lr * 4 + 0] = ea; rinfo[lr * 4 + 1] = eb; rinfo[lr * 4 + 2] = pa; rinfo[lr * 4 + 3] = pb; rgate[lr * 2] = w1; rgate[lr * 2 + 1] = w2; }
            }
        }
        __syncthreads();
        if (F.tid < 32) lbase[F.tid] = atomicAdd(gcount + F.tid, lcnt[F.tid]);
        __syncthreads();
        if (F.tid < 128) { const int lr = F.tid, tok = batch * 128 + lr;
            const unsigned ea = rinfo[lr * 4], eb = rinfo[lr * 4 + 1], pa = rinfo[lr * 4 + 2], pb = rinfo[lr * 4 + 3];
            LIST[(size_t)ea * NTOK + lbase[ea] + pa] = 2 * tok; LIST[(size_t)eb * NTOK + lbase[eb] + pb] = 2 * tok + 1;
            AG[2 * tok] = rgate[lr * 2]; AG[2 * tok + 1] = rgate[lr * 2 + 1]; }
    }
    __syncthreads();
}

struct MoeTab { LAS int* tstart; LAS int* cnt; };
__device__ __forceinline__ MoeTab moe_table(Frame& F) {
    MoeTab T; T.tstart = (LAS int*)(F.lds + LDS_MISC + 3072); T.cnt = T.tstart + 40;
    __syncthreads();
    if (F.tid == 0) { int acc = 0; for (int e = 0; e < NEXP; ++e) { const int c = (int)__hip_atomic_load(F.ctl + CW_GCOUNT + e, __ATOMIC_RELAXED, __HIP_MEMORY_SCOPE_AGENT); T.cnt[e] = c; T.tstart[e] = acc; acc += (c + 255) >> 8; } T.tstart[NEXP] = acc; }
    __syncthreads();
    return T;
}
__device__ __forceinline__ int moe_expert_of_tile(const MoeTab& T, int tile) { int e = 0; for (int i = 1; i < NEXP; ++i) if (T.tstart[i] <= tile) e = i; return e; }

__device__ __forceinline__ void p6_moe_up_simple(Frame& F, const Args& A) {
    const MoeTab T = moe_table(F);
    const bf16* X1B = (const bf16*)(F.ws + WS_X1B); const bf16* WGU = (const bf16*)(F.ws + WS_WGU); bf16* H = (bf16*)(F.ws + WS_H); const int* LIST = (const int*)(F.ws + WS_LIST);
    const int gw = F.bid * NWAVES + F.wave, NGW = F.G * NWAVES, r = F.lane & 31, h = F.lane >> 5;
    const int ntile32 = T.tstart[NEXP] * 8;
    for (int w = gw; w < ntile32 * 16; w += NGW) {
        const int t32 = w / 16, cg = w % 16, tile = t32 >> 3, e = moe_expert_of_tile(T, tile), cnt = T.cnt[e];
        int lrow = (tile - T.tstart[e]) * 256 + (t32 & 7) * 32 + r; if (lrow >= cnt) lrow = cnt - 1;
        const int tok = LIST[(size_t)e * NTOK + lrow] >> 1;
        const bf16* ap = X1B + (size_t)tok * DM + 8 * h;
        const int n = cg * 32 + r;
        const bf16* bg = WGU + ((size_t)e * 1024 + (n / 128) * 256 + (n % 128)) * 1024 + 8 * h; const bf16* bu = bg + (size_t)128 * 1024;
        f32x16 ag = {}, au = {};
        for (int k = 0; k < DM; k += 16) { const bf16x8 a = *(const bf16x8*)(ap + k);
            ag = __builtin_amdgcn_mfma_f32_32x32x16_bf16(a, *(const bf16x8*)(bg + k), ag, 0, 0, 0);
            au = __builtin_amdgcn_mfma_f32_32x32x16_bf16(a, *(const bf16x8*)(bu + k), au, 0, 0, 0); }
#pragma unroll
        for (int i = 0; i < 16; ++i) { const float g = ag[i], s = g * __builtin_amdgcn_rcpf(1.0f + fast_exp2(-g * LOG2E));
            H[(size_t)(t32 * 32 + crow(i, h)) * DEXP + n] = (bf16)f2bf(s * au[i]); }
    }
}
__device__ __forceinline__ void p7_moe_down_simple(Frame& F, const Args& A) {
    const MoeTab T = moe_table(F);
    const bf16* H = (const bf16*)(F.ws + WS_H); const bf16* WD = (const bf16*)(F.ws + WS_WD); bf16* Y = (bf16*)(F.ws + WS_Y);
    const int* LIST = (const int*)(F.ws + WS_LIST); const float* AG = (const float*)(F.ws + WS_AGATE);
    const int gw = F.bid * NWAVES + F.wave, NGW = F.G * NWAVES, r = F.lane & 31, h = F.lane >> 5;
    const int ntile32 = T.tstart[NEXP] * 8;
    for (int w = gw; w < ntile32 * 32; w += NGW) {
        const int t32 = w / 32, cg = w % 32, tile = t32 >> 3, e = moe_expert_of_tile(T, tile), cnt = T.cnt[e];
        const bf16* ap = H + (size_t)(t32 * 32 + r) * DEXP + 8 * h;
        const bf16* bp = WD + ((size_t)e * 1024 + cg * 32 + r) * DEXP + 8 * h;
        f32x16 acc = {};
        for (int k = 0; k < DEXP; k += 16) acc = __builtin_amdgcn_mfma_f32_32x32x16_bf16(*(const bf16x8*)(ap + k), *(const bf16x8*)(bp + k), acc, 0, 0, 0);
#pragma unroll
        for (int i = 0; i < 16; ++i) { const int lrow = (tile - T.tstart[e]) * 256 + (t32 & 7) * 32 + crow(i, h);
            if (lrow < cnt) { const int a = LIST[(size_t)e * NTOK + lrow]; Y[(size_t)a * DM + cg * 32 + r] = (bf16)f2bf(acc[i] * AG[a]); } }
    }
}

#ifndef FASTMASK
#define FASTMASK 442
#endif
namespace mg {
struct MoeOrder {
    MoeTab T; const char* A; const char* Bt; size_t a_tile, b_exp, b_tile; const int* LIST; int G, c, ntiles;
    __device__ __forceinline__ bool next(int i, Unit& u) const {
        const int L = i * G + c; if (L >= ntiles * 4) return false;
        const int tile = L >> 2; const int e = __builtin_amdgcn_readfirstlane(moe_expert_of_tile(T, tile));
        u.pm = tile; u.pn = L & 3; u.e = e; u.lt = tile - __builtin_amdgcn_readfirstlane(T.tstart[e]); return true;
    }
    __device__ __forceinline__ const char* a_base(const Unit& u) const { return A + (size_t)u.pm * a_tile; }
    __device__ __forceinline__ const char* b_base(const Unit& u) const { return Bt + (size_t)u.e * b_exp + (size_t)u.pn * b_tile; }
    __device__ __forceinline__ int row(const Unit& u, int r) const { int lrow = u.lt * 256 + r; const int cnt = T.cnt[u.e]; if (lrow >= cnt) lrow = cnt - 1; return LIST[(size_t)u.e * NTOK + lrow] >> 1; }
};
struct EpiMoeUp {
    static constexpr bool PERM = true, HOOK = false; static constexpr int HK1 = -1, HK2 = -1;
    bf16* H;
    __device__ __forceinline__ void hook(Acc&, const Unit&, int, int, int, int, int) const {}
    __device__ __forceinline__ void operator()(const Acc& acc, const Unit& u, int wr, int wc, int fr, int fq) const {
        const int row0 = u.pm * BM + wr * 64 + fr, col0 = u.pn * 128 + wc * 32 + 8 * fq;
#pragma unroll
        for (int ai = 0; ai < 2; ++ai)
#pragma unroll
            for (int m = 0; m < 4; ++m) { f32x4 h0, h1;
#pragma unroll
                for (int j = 0; j < 4; ++j) { const float g0 = acc[ai][0][m][0][j], g1 = acc[ai][0][m][1][j];
                    h0[j] = g0 * __builtin_amdgcn_rcpf(1.0f + fast_exp2(-g0 * LOG2E)) * acc[ai][1][m][0][j]; h1[j] = g1 * __builtin_amdgcn_rcpf(1.0f + fast_exp2(-g1 * LOG2E)) * acc[ai][1][m][1][j]; }
                u32x4 w; w.x = cvt_pk_bf16(h0[0], h0[1]); w.y = cvt_pk_bf16(h0[2], h0[3]); w.z = cvt_pk_bf16(h1[0], h1[1]); w.w = cvt_pk_bf16(h1[2], h1[3]);
                *(u32x4*)(H + (size_t)(row0 + ai * HALF + m * 16) * DEXP + col0) = w; }
    }
};
struct EpiMoeDown {
    static constexpr bool PERM = true, HOOK = false; static constexpr int HK1 = -1, HK2 = -1;
    bf16* Y; const int* LIST; const float* AG; MoeTab T;
    __device__ __forceinline__ void hook(Acc&, const Unit&, int, int, int, int, int) const {}
    __device__ __forceinline__ void operator()(const Acc& acc, const Unit& u, int wr, int wc, int fr, int fq) const {
        const int col0 = u.pn * BM + wc * 32 + 8 * fq, cnt = T.cnt[u.e];
#pragma unroll
        for (int ai = 0; ai < 2; ++ai)
#pragma unroll
            for (int m = 0; m < 4; ++m) { const int lrow = u.lt * 256 + ai * HALF + wr * 64 + m * 16 + fr;
                if (lrow < cnt) { const int a = LIST[(size_t)u.e * NTOK + lrow]; const float g = AG[a];
#pragma unroll
                    for (int bj = 0; bj < 2; ++bj) { const f32x4 v0 = acc[ai][bj][m][0] * g, v1 = acc[ai][bj][m][1] * g;
                        u32x4 w; w.x = cvt_pk_bf16(v0[0], v0[1]); w.y = cvt_pk_bf16(v0[2], v0[3]); w.z = cvt_pk_bf16(v1[0], v1[1]); w.w = cvt_pk_bf16(v1[2], v1[3]);
                        *(u32x4*)(Y + (size_t)a * DM + col0 + bj * HALF) = w; } } }
    }
};
}
__device__ __forceinline__ void p1_proj_fast(Frame& F, const Args& A) {
    { mg::StaticOrder S; S.init(F.ws + WS_XB, F.ws + WS_WIN, DM, DM, NTOK, PROJW, F.G, F.bid);
      mg::EpiProj E{(bf16*)(F.ws + WS_QKV), (bf16*)(F.ws + WS_GATES)};
      mg::gemm_phase<mg::EpiProj, mg::StaticOrder, false, true>(F.lds, DM, DM, DM, S, E); }
    { mg::StaticOrder S; S.init(F.ws + WS_MEMB, F.ws + WS_WMKV, DM, DM, BATCH * NMEM, 512, F.G, F.bid);
      mg::EpiPlainBf16 E{(bf16*)(F.ws + WS_MEMKV), 512};
      mg::gemm_phase<mg::EpiPlainBf16, mg::StaticOrder, false, false>(F.lds, DM, DM, DM, S, E); }
}
__device__ __forceinline__ void p3_merge_fast(Frame& F, const Args& A) {
    mg::StaticOrder S; S.init(F.ws + WS_YATT, F.ws + WS_WBR, DM, DM, NTOK, DM, F.G, F.bid);
    mg::EpiMerge E{(const bf16*)(F.ws + WS_GATES), (bf16*)(F.ws + WS_MERGED)};
    mg::gemm_phase<mg::EpiMerge, mg::StaticOrder, false, true>(F.lds, DM, DM, DM, S, E);
}
__device__ __forceinline__ void p4_out_fast(Frame& F, const Args& A) {
    mg::StaticOrder S; S.init(F.ws + WS_MERGED, F.ws + WS_WOUT, DM, DM, NTOK, DM, F.G, F.bid);
    mg::EpiOut E{A.in[I_X], (float*)(F.ws + WS_X1)};
    mg::gemm_phase<mg::EpiOut, mg::StaticOrder, false, true>(F.lds, DM, DM, DM, S, E);
}
__device__ __forceinline__ void p6_moe_up_fast(Frame& F, const Args& A) {
    const MoeTab T = moe_table(F);
    mg::MoeOrder S{T, (const char*)(F.ws + WS_X1B), (const char*)(F.ws + WS_WGU), 0, (size_t)1024 * 1024 * 2, (size_t)256 * 1024 * 2, (const int*)(F.ws + WS_LIST), F.G, F.bid, __builtin_amdgcn_readfirstlane(T.tstart[NEXP])};
    mg::EpiMoeUp E{(bf16*)(F.ws + WS_H)};
    mg::gemm_phase<mg::EpiMoeUp, mg::MoeOrder, true, true>(F.lds, DM, DM, DM, S, E);
}
__device__ __forceinline__ void p7_moe_down_fast(Frame& F, const Args& A) {
    const MoeTab T = moe_table(F);
    mg::MoeOrder S{T, (const char*)(F.ws + WS_H), (const char*)(F.ws + WS_WD), (size_t)256 * DEXP * 2, (size_t)1024 * DEXP * 2, (size_t)256 * DEXP * 2, (const int*)(F.ws + WS_LIST), F.G, F.bid, __builtin_amdgcn_readfirstlane(T.tstart[NEXP])};
    mg::EpiMoeDown E{(bf16*)(F.ws + WS_Y), (const int*)(F.ws + WS_LIST), (const float*)(F.ws + WS_AGATE), T};
    mg::gemm_phase<mg::EpiMoeDown, mg::MoeOrder, false, true>(F.lds, DEXP, DEXP, DEXP, S, E);
}

__device__ __forceinline__ void p8_final(Frame& F, const Args& A) {
    const float* X1 = (const float*)(F.ws + WS_X1); const bf16* Y = (const bf16*)(F.ws + WS_Y);
    const int gw = F.bid * NWAVES + F.wave, NGW = F.G * NWAVES, lane = F.lane;
    f32x4 lg[4], lb[4];
#pragma unroll
    for (int j = 0; j < 4; ++j) { lg[j] = *(const f32x4*)(A.in[I_LN2G] + 4 * lane + 256 * j); lb[j] = *(const f32x4*)(A.in[I_LN2B] + 4 * lane + 256 * j); }
    for (int row = gw; row < NTOK; row += NGW) {
        const float* xr = X1 + (size_t)row * DM + 4 * lane; const bf16* y0 = Y + (size_t)(2 * row) * DM + 4 * lane; const bf16* y1 = y0 + DM;
        f32x4 v[4]; float s = 0.f;
#pragma unroll
        for (int j = 0; j < 4; ++j) { const f32x4 x = *(const f32x4*)(xr + 256 * j); const u32x2 a = *(const u32x2*)(y0 + 256 * j), b = *(const u32x2*)(y1 + 256 * j);
            v[j].x = ALPHA * x.x + (bflo(a.x) + bflo(b.x)); v[j].y = ALPHA * x.y + (bfhi(a.x) + bfhi(b.x)); v[j].z = ALPHA * x.z + (bflo(a.y) + bflo(b.y)); v[j].w = ALPHA * x.w + (bfhi(a.y) + bfhi(b.y));
            s += (v[j].x + v[j].y) + (v[j].z + v[j].w); }
        const float mean = wave_sum(s) * (1.0f / DM); float s2 = 0.f;
#pragma unroll
        for (int j = 0; j < 4; ++j) { v[j] = v[j] - mean; s2 += (v[j].x * v[j].x + v[j].y * v[j].y) + (v[j].z * v[j].z + v[j].w * v[j].w); }
        const float rstd = 1.0f / sqrtf(wave_sum(s2) * (1.0f / DM) + LN_EPS);
        float* orow = F.out + (size_t)row * DM + 4 * lane;
#pragma unroll
        for (int j = 0; j < 4; ++j) *(f32x4*)(orow + 256 * j) = v[j] * rstd * lg[j] + lb[j];
    }
}

constexpr int NPHASE = 10;
__global__ void __launch_bounds__(NTHREADS, 2) fwd(Args args) {
    extern __shared__ __attribute__((aligned(16))) unsigned char lds[];
    Frame F;
    F.lds = (LAS unsigned char*)lds; F.tid = threadIdx.x; F.lane = F.tid & 63; F.wave = __builtin_amdgcn_readfirstlane(F.tid >> 6);
    F.G = gridDim.x; F.bid = blockIdx.x; F.ws = args.ws; F.ctl = (unsigned*)(args.ws + WS_CTL); F.out = args.out;
    for (int u = F.tid; u < (LDS_BYTES - LDS_CTL) / 4; u += NTHREADS) ((LAS unsigned*)(F.lds + LDS_CTL))[u] = 0u;
    __syncthreads();
    XcdBarrier bar; bar.bar = F.ctl + CW_BAR; bar.x = 0; bar.st = nullptr;
    const bool multi = (args.ph_hi - args.ph_lo) > 1;
    if (multi) bar = xcd_barrier_post(F.ctl + CW_BAR, (volatile LAS unsigned*)(F.lds + LDS_CTL));
    const int lo = args.ph_lo, hi = args.ph_hi;
#ifndef PHASE_MASK
#define PHASE_MASK 0xFFFF
#endif
#define IN(k) (((PHASE_MASK >> (k)) & 1) && lo <= (k) && (k) < hi)
#define SEAM(k) do { if (IN(k) && IN((k) + 1)) xcd_barrier(bar); } while (0)
#define LAUNDER() do { asm volatile("" : "+s"(F.ws), "+s"(F.out), "+s"(F.ctl), "+v"(F.tid), "+v"(F.lane)); } while (0)
    if (IN(0)) { p0_prologue(F, args); } SEAM(0);
    if (IN(1)) { if (FASTMASK & 2) p1_proj_fast(F, args); else p1_proj_simple(F, args); } SEAM(1);
    if (IN(2)) { p1b_kmean(F, args); } SEAM(2);
    if (IN(3)) { if (FASTMASK & 8) p2_attn_fast(F, args); else p2_attn_simple(F, args); } SEAM(3);
    if (IN(4)) { convert_experts(F, args); __syncthreads(); if (FASTMASK & 16) p3_merge_fast(F, args); else p3_merge_simple(F, args); } SEAM(4);
    if (IN(5)) { if (FASTMASK & 32) p4_out_fast(F, args); else p4_out_simple(F, args); } SEAM(5);
    if (IN(6)) { p5_ln_router(F, args); } SEAM(6);
    if (IN(7)) { if (FASTMASK & 128) p6_moe_up_fast(F, args); else p6_moe_up_simple(F, args); } SEAM(7);
    if (IN(8)) { if (FASTMASK & 256) p7_moe_down_fast(F, args); else p7_moe_down_simple(F, args); } SEAM(8);
    if (IN(9)) { p8_final(F, args); }
#undef IN
#undef SEAM
}

extern "C" void kernel_launch(void* const* d_in, const int* in_sizes, int n_in, void* d_out, int out_size, void* d_ws, size_t ws_size, hipStream_t stream) {
    static int grid = 0;
    if (grid == 0) {
        if (n_in != 20 || in_sizes[0] != NTOK * DM || out_size != NTOK * DM || ws_size < WS_END) { fprintf(stderr, "kernel_launch: unexpected shapes (n_in %d, ws %zu)\n", n_in, ws_size); grid = -1; return; }
        int dev = 0, cus = 0, per_cu = 0;
        if (hipGetDevice(&dev) != hipSuccess || hipDeviceGetAttribute(&cus, hipDeviceAttributeMultiprocessorCount, dev) != hipSuccess) { grid = -1; return; }
        if (hipFuncSetAttribute((const void*)fwd, hipFuncAttributeMaxDynamicSharedMemorySize, LDS_BYTES) != hipSuccess) { fprintf(stderr, "kernel_launch: hipFuncSetAttribute failed\n"); grid = -1; return; }
        if (hipOccupancyMaxActiveBlocksPerMultiprocessor(&per_cu, (const void*)fwd, NTHREADS, LDS_BYTES) != hipSuccess || per_cu < 1) { fprintf(stderr, "kernel_launch: occupancy query says %d\n", per_cu); }
        (void)hipGetLastError();
        grid = cus;
    }
    if (grid < 0) return;
    if (hipMemsetAsync((char*)d_ws + WS_CTL, 0, CTL_ZERO_BYTES, stream) != hipSuccess) return;
    Args a{};
    for (int i = 0; i < 20; ++i) a.in[i] = (const float*)d_in[i];
    a.out = (float*)d_out; a.ws = (unsigned char*)d_ws;
#if N_LAUNCH_PER_PHASE
    for (int p = 0; p < NPHASE; ++p) { a.ph_lo = p; a.ph_hi = p + 1; hipLaunchKernelGGL(fwd, dim3(grid), dim3(NTHREADS), LDS_BYTES, stream, a); }
#else
    a.ph_lo = 0; a.ph_hi = NPHASE; hipLaunchKernelGGL(fwd, dim3(grid), dim3(NTHREADS), LDS_BYTES, stream, a);
#endif
}
```

```cpp
#include <hip/hip_runtime.h>
#include <cstdio>
#include <cstdint>

#ifndef N_LAUNCH_PER_PHASE
#define N_LAUNCH_PER_PHASE 0
#endif
#ifndef FAST_GEMM
#define FAST_GEMM 0
#endif
#ifndef FAST_ATTN
#define FAST_ATTN 0
#endif

#define GAS __attribute__((address_space(1)))
#define LAS __attribute__((address_space(3)))
typedef unsigned short bf16;
typedef short bf16x8 __attribute__((ext_vector_type(8)));
typedef float f32x4 __attribute__((ext_vector_type(4)));
typedef float f32x2 __attribute__((ext_vector_type(2)));
typedef float f32x16 __attribute__((ext_vector_type(16)));
typedef unsigned u32x4 __attribute__((ext_vector_type(4)));
typedef unsigned u32x2 __attribute__((ext_vector_type(2)));

constexpr int BATCH = 8, SEQ = 4096, DM = 1024, NTOK = BATCH * SEQ;
constexpr int HD = 64, NH_A = 6, NH_B = 6, NH_M = 4, NMEM = 256;
constexpr int QKVW = 2560, GATEW = 3072, PROJW = QKVW + GATEW;
constexpr int C_QA = 0, C_KA = 384, C_VA = 768, C_QB = 1152, C_KB = 1536, C_VB = 1920, C_QM = 2304;
constexpr int NBLK = 16;
constexpr int NEXP = 32, DEXP = 512, NGRP = 4, EPG = 8;
constexpr int NASG = NTOK * 2;
constexpr int MAXTILES = NASG / 256 + NEXP;
constexpr float ALPHA = 1.189207115002721f;
constexpr float LN_EPS = 1e-5f;
constexpr float LOG2E = 1.4426950408889634f;
constexpr float C2 = 0.125f * LOG2E;
constexpr float NEGBIG = -1e30f;

constexpr size_t MiB = 1u << 20;
constexpr size_t WS_CTL = 0, CTL_ZERO_BYTES = 1 * MiB;
constexpr size_t WS_KMEAN = 512 * 1024;
constexpr size_t WS_WRT = 1 * MiB + 512 * 1024;
constexpr size_t WS_WRB = 1 * MiB;
constexpr size_t WS_MEMKV = 2 * MiB;
constexpr size_t WS_MEMB = 4 * MiB;
constexpr size_t WS_LIST = 8 * MiB;
constexpr size_t WS_AGATE = 12 * MiB;
constexpr size_t WS_GATES = 16 * MiB;
constexpr size_t WS_X1 = 16 * MiB;
constexpr size_t WS_X1B = 144 * MiB;
constexpr size_t WS_Y = 144 * MiB;
constexpr size_t WS_QKV = 208 * MiB;
constexpr size_t WS_MERGED = 208 * MiB;
constexpr size_t WS_WGU = 272 * MiB;
constexpr size_t WS_WD = 336 * MiB;
constexpr size_t WS_XB = 368 * MiB;
constexpr size_t WS_YATT = 368 * MiB;
constexpr size_t WS_H = 368 * MiB;
constexpr size_t WS_WIN = 432 * MiB;
constexpr size_t WS_WMKV = 443 * MiB;
constexpr size_t WS_WBR = 444 * MiB;
constexpr size_t WS_WOUT = 446 * MiB;
constexpr size_t WS_END = 448 * MiB;
constexpr int CW_GCOUNT = 64;
constexpr int CW_WQ = 128;
constexpr int CW_BAR = 4096;

constexpr int RING_BYTES = 131072;
constexpr int P5_W_BYTES = 36 * 1024 * 4;
constexpr int LDS_MISC = P5_W_BYTES;
constexpr int LDS_CTL = LDS_MISC + 4096;
constexpr int LDS_BYTES = LDS_CTL + 512;
constexpr int NWAVES = 8, NTHREADS = 512;

__device__ __forceinline__ unsigned f2bf(float f) { unsigned u = __builtin_bit_cast(unsigned, f); return (u + 0x7fffu + ((u >> 16) & 1u)) >> 16; }
__device__ __forceinline__ unsigned pk2(float lo, float hi) { return f2bf(lo) | (f2bf(hi) << 16); }
__device__ __forceinline__ float bf2f(unsigned short b) { return __builtin_bit_cast(float, (unsigned)b << 16); }
__device__ __forceinline__ float bflo(unsigned w) { return __builtin_bit_cast(float, w << 16); }
__device__ __forceinline__ float bfhi(unsigned w) { return __builtin_bit_cast(float, w & 0xffff0000u); }
__device__ __forceinline__ float wave_sum(float v) {
#pragma unroll
    for (int o = 1; o < 64; o <<= 1) v += __shfl_xor(v, o);
    return v;
}
__device__ __forceinline__ float wave_max(float v) {
#pragma unroll
    for (int o = 1; o < 64; o <<= 1) v = fmaxf(v, __shfl_xor(v, o));
    return v;
}
__device__ __forceinline__ float fast_exp2(float x) { return __builtin_amdgcn_exp2f(x); }
__device__ __forceinline__ float fast_log2(float x) { return __builtin_amdgcn_logf(x); }
__device__ __forceinline__ int crow(int r, int hi) { return (r & 3) + 8 * (r >> 2) + 4 * hi; }
__device__ __forceinline__ int t5_bucket(int rel) {
    if (rel < 16) return rel;
    const int l = 16 + (int)(log2f((float)rel * (1.0f / 16.0f)) * (16.0f / 3.0f));
    return l < 31 ? l : 31;
}

#define XB_TMO      128
#define XB_XCNT(j)  (256  + 64 * (j))
#define XB_XSUB(j)  (1280 + 64 * (j))
#define XB_XGEN(j)  (2304 + 64 * (j))
#define XB_TOP      3328
#define XB_TOPGEN   3392
#define XCD_BAR_WORDS 3456
#define XB_SPIN_CAP (1u << 22)
__device__ __forceinline__ unsigned xb_ld(unsigned* p)              { return __hip_atomic_load(p, __ATOMIC_RELAXED, __HIP_MEMORY_SCOPE_AGENT); }
__device__ __forceinline__ unsigned xb_add(unsigned* p, unsigned v) { return __hip_atomic_fetch_add(p, v, __ATOMIC_RELAXED, __HIP_MEMORY_SCOPE_AGENT); }
__device__ __forceinline__ unsigned xb_xcc_id() { return (unsigned)__builtin_amdgcn_s_getreg((3 << 11) | 20) & 0xFu; }
#define XB_SPIN(cond, bar) do { unsigned _sp = 0; while (cond) { __builtin_amdgcn_s_sleep(1); \
    if ((++_sp & 255u) == 0u) { if (xb_ld(&(bar)[XB_TMO])) break; if (_sp > XB_SPIN_CAP) { atomicAdd(&(bar)[XB_TMO], 1u); break; } } } } while (0)
struct XcdBarrier { unsigned* bar; unsigned x; volatile LAS unsigned* st; };
__device__ __forceinline__ XcdBarrier xcd_barrier_post(unsigned* bar, volatile LAS unsigned* st) {
    XcdBarrier b; b.bar = bar; b.x = xb_xcc_id(); b.st = st;
    if (threadIdx.x == 0) (void)xb_add(&bar[XB_XCNT(b.x)], 1u);
    return b;
}
__device__ __forceinline__ void xcd_barrier_complete(unsigned* bar, unsigned x, unsigned& nloc, unsigned& nx) {
    const unsigned G = gridDim.x * gridDim.y * gridDim.z;
    unsigned sum, cnt, mine, sp = 0u;
    for (;;) {
        sum = 0u; cnt = 0u; mine = 0u;
#pragma unroll
        for (unsigned j = 0; j < 16; ++j) { const unsigned c = xb_ld(&bar[XB_XCNT(j)]); sum += c; cnt += (c > 0u) ? 1u : 0u; mine = (j == x) ? c : mine; }
        if (sum == G) break;
        __builtin_amdgcn_s_sleep(1);
        if ((++sp & 255u) == 0u) { if (xb_ld(&bar[XB_TMO])) break; if (sp > XB_SPIN_CAP) { atomicAdd(&bar[XB_TMO], 1u); break; } }
    }
    nloc = mine > 0u ? mine : 1u; nx = cnt > 0u ? cnt : 1u;
}
__device__ __forceinline__ void xcd_barrier(const XcdBarrier& b) {
    asm volatile("s_waitcnt vmcnt(0)" ::: "memory");
    __syncthreads();
    if (threadIdx.x == 0) {
        unsigned* bar = b.bar;
        __builtin_amdgcn_s_waitcnt(0);
        unsigned nloc = b.st[0], nx = b.st[1];
        if (nloc == 0u) { xcd_barrier_complete(bar, b.x, nloc, nx); b.st[0] = nloc; b.st[1] = nx; }
        const unsigned old = xb_add(&bar[XB_XSUB(b.x)], 1u);
        const unsigned gen = old / nloc;
        if (old + 1u == (gen + 1u) * nloc) {
            __builtin_amdgcn_fence(__ATOMIC_RELEASE, "agent");
            asm volatile("s_waitcnt vmcnt(0)" ::: "memory");
            const unsigned og = xb_add(&bar[XB_TOP], 1u);
            const unsigned tg = og / nx;
            if (og + 1u == (tg + 1u) * nx) xb_add(&bar[XB_TOPGEN], 1u);
            else XB_SPIN(xb_ld(&bar[XB_TOPGEN]) == tg, bar);
            __builtin_amdgcn_fence(__ATOMIC_ACQUIRE, "agent");
            xb_add(&bar[XB_XGEN(b.x)], 1u);
            asm volatile("s_waitcnt vmcnt(0)" ::: "memory");
        } else {
            XB_SPIN(xb_ld(&bar[XB_XGEN(b.x)]) == gen, bar);
            __builtin_amdgcn_fence(__ATOMIC_ACQUIRE, "agent");
            asm volatile("s_waitcnt vmcnt(0)" ::: "memory");
        }
    }
    __syncthreads();
}

struct Args { const float* in[20]; float* out; unsigned char* ws; int ph_lo, ph_hi; };
struct Frame {
    LAS unsigned char* lds;
    unsigned* ctl;
    int tid, lane, wave, G, bid;
    unsigned char* ws;
    float* out;
};
enum { I_X = 0, I_MEM, I_WIN, I_WMKV, I_RELB, I_WBA, I_WBB, I_WBM, I_WOUT, I_LN1G, I_LN1B, I_WRG, I_BRG, I_WRE, I_BRE, I_WG, I_WU, I_WD, I_LN2G, I_LN2B };

__device__ __forceinline__ void transpose_item(const float* W, size_t srcN, int k0, int n0, bf16* WT, size_t ldt, size_t drow0, int dcol0, LAS float* scr, int lane) {
#pragma unroll 8
    for (int i = 0; i < 32; ++i) { const int kk = 2 * i + (lane >> 5); scr[kk * 33 + (lane & 31)] = W[(size_t)(k0 + kk) * srcN + n0 + (lane & 31)]; }
    asm volatile("s_waitcnt lgkmcnt(0)" ::: "memory");
    const int c = lane & 7;
#pragma unroll
    for (int j = 0; j < 4; ++j) { const int n = (lane >> 3) + 8 * j; const LAS float* s = scr + (8 * c) * 33 + n;
        u32x4 o; o.x = pk2(s[0 * 33], s[1 * 33]); o.y = pk2(s[2 * 33], s[3 * 33]); o.z = pk2(s[4 * 33], s[5 * 33]); o.w = pk2(s[6 * 33], s[7 * 33]);
        *(u32x4*)(WT + (drow0 + n) * ldt + dcol0 + k0 + 8 * c) = o; }
    asm volatile("s_waitcnt lgkmcnt(0)" ::: "memory");
}
__device__ __forceinline__ void convert_rows_bf16(const float* src, bf16* dst, size_t n_elems, int gthread, int nthreads) {
    const size_t nv = n_elems / 8;
    for (size_t i = gthread; i < nv; i += nthreads) {
        const f32x4 a = *(const f32x4*)(src + i * 8), b = *(const f32x4*)(src + i * 8 + 4);
        u32x4 o; o.x = pk2(a.x, a.y); o.y = pk2(a.z, a.w); o.z = pk2(b.x, b.y); o.w = pk2(b.z, b.w);
        *(u32x4*)(dst + i * 8) = o;
    }
}
__device__ __forceinline__ void p0_prologue(Frame& F, const Args& A) {
    LAS float* scr = (LAS float*)(F.lds + F.wave * 16384);
    const int gw = F.bid * NWAVES + F.wave, NGW = F.G * NWAVES;
    const int gt = F.bid * NTHREADS + F.tid, NGT = F.G * NTHREADS;
    bf16* WIN = (bf16*)(F.ws + WS_WIN); bf16* WMKV = (bf16*)(F.ws + WS_WMKV); bf16* WBR = (bf16*)(F.ws + WS_WBR); bf16* WOUT = (bf16*)(F.ws + WS_WOUT);
    constexpr int I_IN = 16 * (PROJW / 32), I_MK = 16 * (512 / 32), I_BA = 6 * 32, I_BB = 6 * 32, I_BM = 4 * 32, I_WO = 16 * 32;
    constexpr int NITEMS = I_IN + I_MK + I_BA + I_BB + I_BM + I_WO;
    for (int it = gw; it < NITEMS; it += NGW) {
        int r = it;
        if (r < I_IN) { const int nb = PROJW / 32; transpose_item(A.in[I_WIN], PROJW, 64 * (r / nb), 32 * (r % nb), WIN, 1024, 32 * (r % nb), 0, scr, F.lane); continue; } r -= I_IN;
        if (r < I_MK) { const int nb = 16; transpose_item(A.in[I_WMKV], 512, 64 * (r / nb), 32 * (r % nb), WMKV, 1024, 32 * (r % nb), 0, scr, F.lane); continue; } r -= I_MK;
        if (r < I_BA) { const int nb = 32; transpose_item(A.in[I_WBA], 1024, 64 * (r / nb), 32 * (r % nb), WBR, 1024, 32 * (r % nb), 0, scr, F.lane); continue; } r -= I_BA;
        if (r < I_BB) { const int nb = 32; transpose_item(A.in[I_WBB], 1024, 64 * (r / nb), 32 * (r % nb), WBR, 1024, 32 * (r % nb), 384, scr, F.lane); continue; } r -= I_BB;
        if (r < I_BM) { const int nb = 32; transpose_item(A.in[I_WBM], 1024, 64 * (r / nb), 32 * (r % nb), WBR, 1024, 32 * (r % nb), 768, scr, F.lane); continue; } r -= I_BM;
        { const int nb = 32; transpose_item(A.in[I_WOUT], 1024, 64 * (r / nb), 32 * (r % nb), WOUT, 1024, 32 * (r % nb), 0, scr, F.lane); }
    }
    convert_rows_bf16(A.in[I_X], (bf16*)(F.ws + WS_XB), (size_t)NTOK * DM, gt, NGT);
    convert_rows_bf16(A.in[I_MEM], (bf16*)(F.ws + WS_MEMB), (size_t)BATCH * NMEM * DM, gt, NGT);
    float* WRT = (float*)(F.ws + WS_WRT);
    for (int i = gt; i < 36 * 1024; i += NGT) { const int o = i >> 10, k = i & 1023; WRT[i] = o < 4 ? A.in[I_WRG][k * 4 + o] : A.in[I_WRE][k * 32 + (o - 4)]; }
    if (gt < 36) WRT[36 * 1024 + gt] = gt < 4 ? A.in[I_BRG][gt] : A.in[I_BRE][gt - 4];
    bf16* WRB = (bf16*)(F.ws + WS_WRB);
    for (int i = gt; i < 8 * 4 * 3 * 2 * 64 * 8; i += NGT) {
        const int jj = i & 7, ln = (i >> 3) & 63, hl = (i >> 9) & 1, r = i >> 10, cb = r % 3, s_ = (r / 3) & 3, kr = r / 12;
        const int col = 16 * cb + (ln & 15), k = kr * 128 + 32 * s_ + 8 * (ln >> 4) + jj;
        const float w = col < 4 ? A.in[I_WRG][k * 4 + col] : (col < 36 ? A.in[I_WRE][k * 32 + (col - 4)] : 0.f);
        const unsigned h_ = f2bf(w); const float wl = w - __builtin_bit_cast(float, h_ << 16);
        WRB[i] = (bf16)(hl ? f2bf(wl) : h_);
    }
}
__device__ __forceinline__ void convert_experts(Frame& F, const Args& A) {
    LAS float* scr = (LAS float*)(F.lds + F.wave * 16384);
    const int gw = F.bid * NWAVES + F.wave, NGW = F.G * NWAVES;
    bf16* WGU = (bf16*)(F.ws + WS_WGU); bf16* WD = (bf16*)(F.ws + WS_WD);
    constexpr int PER_GU = 16 * 16;
    constexpr int PER_D = 8 * 32;
    constexpr int NIT = NEXP * (2 * PER_GU + PER_D);
    for (int it = gw; it < NIT; it += NGW) {
        const int e = it / (2 * PER_GU + PER_D); int r = it % (2 * PER_GU + PER_D);
        if (r < 2 * PER_GU) { const int up = r / PER_GU; r %= PER_GU; const int kb = r / 16, nb = r % 16, n0 = 32 * nb;
            const float* src = (up ? A.in[I_WU] : A.in[I_WG]) + (size_t)e * 1024 * 512;
            const size_t drow0 = (size_t)e * 1024 + (n0 / 128) * 256 + up * 128 + (n0 % 128);
            transpose_item(src, 512, 64 * kb, n0, WGU, 1024, drow0, 0, scr, F.lane);
        } else { r -= 2 * PER_GU; const int kb = r / 32, nb = r % 32;
            transpose_item(A.in[I_WD] + (size_t)e * 512 * 1024, 1024, 64 * kb, 32 * nb, WD, 512, (size_t)e * 1024 + 32 * nb, 0, scr, F.lane); }
    }
}

template <class AF, class BF, class EF>
__device__ __forceinline__ void sg_phase(Frame& F, int mt, int nt, int K, AF arow, BF brow, EF epi) {
    const int gw = F.bid * NWAVES + F.wave, NGW = F.G * NWAVES, r = F.lane & 31, h = F.lane >> 5;
    for (int tile = gw; tile < mt * nt; tile += NGW) {
        const int tm = tile / nt, tn = tile % nt;
        const bf16* ap = arow(tm * 32 + r) + 8 * h;
        const bf16* bp = brow(tn * 32 + r) + 8 * h;
        f32x16 acc = {};
        for (int k = 0; k < K; k += 16) {
            const bf16x8 a = *(const bf16x8*)(ap + k), b = *(const bf16x8*)(bp + k);
            acc = __builtin_amdgcn_mfma_f32_32x32x16_bf16(a, b, acc, 0, 0, 0);
        }
#pragma unroll
        for (int i = 0; i < 16; ++i) epi(tm * 32 + crow(i, h), tn * 32 + r, acc[i]);
    }
}

__device__ __forceinline__ float sigmoid_clamped(float v);
__device__ __forceinline__ bool is_qcol(int c);

namespace mg {
constexpr int BM = 256, BK = 64, HALF = 128, HTB = HALF * BK * 2, STAGE_BYTES = 8 * HTB, NXCD = 8, WGM = 8;
__device__ __forceinline__ int lds_byte(int r, int c) { const int st = (r >> 4) * 2 + (c >> 5), rr = r & 15, cc = c & 31, ob = rr * 64 + cc * 2; return st * 1024 + (ob ^ (((ob >> 9) & 1) << 5)); }
__device__ __forceinline__ void stage_rc(int b, int& R, int& C) { const int st = b / 1024, sb = b % 1024, swz = sb ^ (((sb >> 9) & 1) << 5); R = (st >> 1) * 16 + swz / 64; C = (st & 1) * 32 + (swz % 64) / 2; }
__device__ __forceinline__ int perm32(int rho) { const int n = rho >> 4, i = rho & 15; return 8 * (i >> 2) + 4 * n + (i & 3); }
struct Unit { int pm, pn, e, lt; };
__device__ __forceinline__ unsigned cvt_pk_bf16(float lo, float hi) { unsigned r; asm volatile("v_cvt_pk_bf16_f32 %0, %1, %2" : "=v"(r) : "v"(lo), "v"(hi)); return r; }

struct StaticOrder {
    const char* A; const char* Bt; size_t a_tile, b_tile;
    int nM, nN, nwg, G, c;
    __device__ __forceinline__ void init(const void* A_, const void* Bt_, int lda, int ldb, int M, int N, int G_, int c_) { A = (const char*)A_; Bt = (const char*)Bt_; a_tile = (size_t)256 * lda * 2; b_tile = (size_t)256 * ldb * 2; nM = M / BM; nN = N / BM; nwg = nM * nN; G = G_; c = c_; }
    __device__ __forceinline__ bool next(int i, Unit& u) const {
        const long L = (long)i * G + c; if (L >= nwg) return false;
        int wgid = (int)L; { const int q = nwg / NXCD, r = nwg % NXCD, xcd = wgid % NXCD, off = wgid / NXCD; wgid = (xcd < r ? xcd * (q + 1) : r * (q + 1) + (xcd - r) * q) + off; }
        const int nig = WGM * nN, gid = wgid / nig, fm = gid * WGM, gsz = (nM - fm) < WGM ? (nM - fm) : WGM;
        u.pm = fm + ((wgid % nig) % gsz); u.pn = (wgid % nig) / gsz; u.e = 0; u.lt = 0; return true;
    }
    __device__ __forceinline__ const char* a_base(const Unit& u) const { return A + (size_t)u.pm * a_tile; }
    __device__ __forceinline__ const char* b_base(const Unit& u) const { return Bt + (size_t)u.pn * b_tile; }
    __device__ __forceinline__ int row(const Unit&, int) const { return 0; }
};

template <class Epi, class Sched, bool GATHER, bool ALIGN_EPI>
__device__ __forceinline__ void gemm_phase(LAS unsigned char* lds, const int lda, const int ldb, const int K, const Sched& S, const Epi& E) {
    const int tid = threadIdx.x, wid = __builtin_amdgcn_readfirstlane(tid >> 6), lane = tid & 63, wr = wid >> 2, wc = wid & 3, fr = lane & 15, fq = lane >> 4;
    const int nt = K / BK;
    int Rr[2], Cc[2]; unsigned voffB[2], cvA[2][2], nvA[2][2];
#pragma unroll
    for (int i = 0; i < 2; ++i) { stage_rc(tid * 16 + i * 8192, Rr[i], Cc[i]); const int Rb = Epi::PERM ? ((Rr[i] & ~31) + perm32(Rr[i] & 31)) : Rr[i];
        voffB[i] = (unsigned)(Rb * ldb + Cc[i]) * 2u;
#pragma unroll
        for (int h = 0; h < 2; ++h) { cvA[h][i] = (unsigned)((Rr[i] + HALF * h) * lda + Cc[i]) * 2u; nvA[h][i] = cvA[h][i]; } }
    const size_t kstep = (size_t)(BK * 2);
    const size_t hstepB = (size_t)HALF * ldb * 2;
    const unsigned ldsw = (unsigned)wid * 1024u;
    const int aoff = lds_byte(wr * 64 + fr, fq * 8), boff = lds_byte(wc * 32 + fr, fq * 8);
#define MG_SA(b, h) (((b) * 2 + (h)) * mg::HTB)
#define MG_SB(b, h) ((4 + (b) * 2 + (h)) * mg::HTB)
#define MG_STAGE(bufoff, gbase, o0, o1) do { \
        __builtin_amdgcn_global_load_lds((const unsigned*)((const char*)(gbase) + (o0)), (LAS unsigned*)(lds + (bufoff) + ldsw), 16, 0, 0); \
        __builtin_amdgcn_global_load_lds((const unsigned*)((const char*)(gbase) + (o1)), (LAS unsigned*)(lds + (bufoff) + ldsw + 8192), 16, 0, 0); } while (0)
#define MG_LDA(dst, b, h) do { _Pragma("unroll") for (int m = 0; m < 4; ++m) _Pragma("unroll") for (int k = 0; k < 2; ++k) dst[m][k] = *(const LAS bf16x8*)(lds + MG_SA(b, h) + aoff + m * 2048 + k * 1024); } while (0)
#define MG_LDB(dst, b, h) do { _Pragma("unroll") for (int n = 0; n < 2; ++n) _Pragma("unroll") for (int k = 0; k < 2; ++k) dst[n][k] = *(const LAS bf16x8*)(lds + MG_SB(b, h) + boff + n * 2048 + k * 1024); } while (0)
#define MG_MMA(ai, bj, At, Bt) do { __builtin_amdgcn_s_setprio(1); _Pragma("unroll") for (int m = 0; m < 4; ++m) _Pragma("unroll") for (int n = 0; n < 2; ++n) _Pragma("unroll") for (int k = 0; k < 2; ++k) \
        acc[ai][bj][m][n] = __builtin_amdgcn_mfma_f32_16x16x32_bf16(Bt[n][k], At[m][k], acc[ai][bj][m][n], 0, 0, 0); __builtin_amdgcn_s_setprio(0); } while (0)
#define MG_WAIT_V(n) asm volatile("s_waitcnt vmcnt(" #n ")" ::: "memory")
#define MG_WAIT_L(n) asm volatile("s_waitcnt lgkmcnt(" #n ")" ::: "memory")
#define MG_BAR __builtin_amdgcn_s_barrier()
#define MG_SCHED __builtin_amdgcn_sched_barrier(0)
    Unit cur, nxt; int ui = 0;
    if (!S.next(0, cur)) return;
    f32x4 acc[2][2][4][2];
#pragma unroll
    for (int a = 0; a < 2; ++a)
#pragma unroll
        for (int b = 0; b < 2; ++b)
#pragma unroll
            for (int m = 0; m < 4; ++m)
#pragma unroll
                for (int n = 0; n < 2; ++n) acc[a][b][m][n] = (f32x4){0.f, 0.f, 0.f, 0.f};
    bf16x8 At[4][2], B0[2][2], B1[2][2];
    const char* cA = S.a_base(cur); const char* cB = S.b_base(cur);
    if constexpr (GATHER) {
#pragma unroll
        for (int h = 0; h < 2; ++h)
#pragma unroll
            for (int i = 0; i < 2; ++i) cvA[h][i] = (unsigned)S.row(cur, Rr[i] + HALF * h) * (unsigned)(lda * 2) + (unsigned)Cc[i] * 2u;
    }
    MG_STAGE(MG_SB(0, 0), cB, voffB[0], voffB[1]); MG_STAGE(MG_SB(0, 1), cB + hstepB, voffB[0], voffB[1]); MG_STAGE(MG_SA(0, 0), cA, cvA[0][0], cvA[0][1]); MG_STAGE(MG_SA(0, 1), cA, cvA[1][0], cvA[1][1]);
    if (wr == 1) MG_BAR;
    MG_WAIT_V(2); MG_BAR;
    MG_STAGE(MG_SB(1, 0), cB + kstep, voffB[0], voffB[1]); MG_STAGE(MG_SA(1, 0), cA + kstep, cvA[0][0], cvA[0][1]); MG_STAGE(MG_SB(1, 1), cB + hstepB + kstep, voffB[0], voffB[1]);
    MG_WAIT_V(6); MG_BAR;
    for (;;) {
        const bool has_next = S.next(ui + 1, nxt);
        const char* nA = has_next ? S.a_base(nxt) : cA; const char* nB = has_next ? S.b_base(nxt) : cB;
        if constexpr (GATHER) {
#pragma unroll
            for (int h = 0; h < 2; ++h)
#pragma unroll
                for (int i = 0; i < 2; ++i) nvA[h][i] = has_next ? (unsigned)S.row(nxt, Rr[i] + HALF * h) * (unsigned)(lda * 2) + (unsigned)Cc[i] * 2u : cvA[h][i];
        }
        for (int t = 0; t < nt; t += 2) {
            const bool last = (t == nt - 2);
            if constexpr (Epi::HOOK) { if (t == Epi::HK1 || t == Epi::HK2) E.hook(acc, cur, t, wr, wc, fr, fq); }
            const char* a1 = cA + (size_t)(t + 1) * kstep;
            const char* a2 = last ? nA : cA + (size_t)(t + 2) * kstep; const char* b2 = last ? nB : cB + (size_t)(t + 2) * kstep;
            const char* a3 = a2 + kstep; const char* b3 = b2 + kstep;
            unsigned x00 = cvA[0][0], x01 = cvA[0][1], x10 = cvA[1][0], x11 = cvA[1][1];
            if constexpr (GATHER) { if (last) { x00 = nvA[0][0]; x01 = nvA[0][1]; x10 = nvA[1][0]; x11 = nvA[1][1]; } }
            MG_LDB(B0, 0, 0); MG_LDB(B1, 0, 1); MG_SCHED; MG_LDA(At, 0, 0); MG_STAGE(MG_SA(1, 1), a1, cvA[1][0], cvA[1][1]);
            MG_WAIT_V(8); MG_WAIT_L(0); MG_BAR; MG_MMA(0, 0, At, B0); MG_MMA(0, 1, At, B1); MG_BAR; MG_SCHED;
            MG_LDA(At, 0, 1); MG_STAGE(MG_SB(0, 0), b2, voffB[0], voffB[1]); MG_STAGE(MG_SB(0, 1), b2 + hstepB, voffB[0], voffB[1]); MG_STAGE(MG_SA(0, 0), a2, x00, x01);
            MG_WAIT_V(8); MG_WAIT_L(0); MG_BAR; MG_MMA(1, 0, At, B0); MG_MMA(1, 1, At, B1); MG_BAR; MG_SCHED;
            MG_LDB(B0, 1, 0); MG_LDB(B1, 1, 1); MG_SCHED; MG_LDA(At, 1, 0); MG_STAGE(MG_SA(0, 1), a2, x10, x11);
            MG_WAIT_V(8); MG_WAIT_L(0); MG_BAR; MG_MMA(0, 0, At, B0); MG_MMA(0, 1, At, B1); MG_BAR; MG_SCHED;
            MG_LDA(At, 1, 1); MG_STAGE(MG_SB(1, 0), b3, voffB[0], voffB[1]); MG_STAGE(MG_SB(1, 1), b3 + hstepB, voffB[0], voffB[1]); MG_STAGE(MG_SA(1, 0), a3, x00, x01);
            MG_WAIT_V(8); MG_WAIT_L(0); MG_BAR; MG_MMA(1, 0, At, B0); MG_MMA(1, 1, At, B1); MG_BAR; MG_SCHED;
        }
        if constexpr (ALIGN_EPI) { if (wr == 0) MG_BAR; }
        E(acc, cur, wr, wc, fr, fq);
        if (!has_next) break;
#pragma unroll
        for (int a = 0; a < 2; ++a)
#pragma unroll
            for (int b = 0; b < 2; ++b)
#pragma unroll
                for (int m = 0; m < 4; ++m)
#pragma unroll
                    for (int n = 0; n < 2; ++n) acc[a][b][m][n] = (f32x4){0.f, 0.f, 0.f, 0.f};
        cur = nxt; cA = nA; cB = nB; ++ui;
        if constexpr (GATHER) {
#pragma unroll
            for (int h = 0; h < 2; ++h)
#pragma unroll
                for (int i = 0; i < 2; ++i) cvA[h][i] = nvA[h][i];
        }
        if constexpr (ALIGN_EPI) { if (wr == 1) MG_BAR; }
    }
    MG_WAIT_V(0);
    if constexpr (!ALIGN_EPI) { if (wr == 0) MG_BAR; }
    MG_BAR;
#undef MG_SA
#undef MG_SB
#undef MG_STAGE
#undef MG_LDA
#undef MG_LDB
#undef MG_MMA
#undef MG_WAIT_V
#undef MG_WAIT_L
#undef MG_BAR
#undef MG_SCHED
}

typedef f32x4 Acc[2][2][4][2];
struct EpiProj {
    static constexpr bool PERM = true, HOOK = false; static constexpr int HK1 = -1, HK2 = -1;
    bf16* QKV; bf16* GT; float* KM;
    __device__ __forceinline__ void hook(Acc&, const Unit&, int, int, int, int, int) const {}
    __device__ __forceinline__ void operator()(const Acc& acc, const Unit& u, int wr, int wc, int fr, int fq) const {
        const int row0 = u.pm * BM + wr * 64 + fr, col0 = u.pn * BM + wc * 32 + 8 * fq;
        const bool gate = col0 >= QKVW;
        if (u.pn == 1 || u.pn == 2) {
#pragma unroll
            for (int bj = 0; bj < 2; ++bj) { if (u.pn == 1 && bj == 0) continue;
#pragma unroll
                for (int n = 0; n < 2; ++n) { f32x4 cs = (f32x4){0.f, 0.f, 0.f, 0.f};
#pragma unroll
                    for (int ai = 0; ai < 2; ++ai)
#pragma unroll
                        for (int m = 0; m < 4; ++m) cs = cs + acc[ai][bj][m][n];
#pragma unroll
                    for (int j = 0; j < 4; ++j) { float v = cs[j]; v += __shfl_xor(v, 1); v += __shfl_xor(v, 2); v += __shfl_xor(v, 4); v += __shfl_xor(v, 8); cs[j] = v; }
                    if (fr == 0) { float* kp = KM + (size_t)u.pm * 512 + (col0 - 256) + bj * HALF + 4 * n;
#pragma unroll
                        for (int j = 0; j < 4; ++j) unsafeAtomicAdd(kp + j, cs[j]); } } }
        }
#pragma unroll
        for (int ai = 0; ai < 2; ++ai)
#pragma unroll
            for (int m = 0; m < 4; ++m) { const size_t row = (size_t)(row0 + ai * HALF + m * 16);
#pragma unroll
                for (int bj = 0; bj < 2; ++bj) { const int c = col0 + bj * HALF; f32x4 v0 = acc[ai][bj][m][0], v1 = acc[ai][bj][m][1]; bf16* dst;
                    if (gate) { dst = GT + row * GATEW + (c - QKVW);
#pragma unroll
                        for (int j = 0; j < 4; ++j) { v0[j] = sigmoid_clamped(v0[j]); v1[j] = sigmoid_clamped(v1[j]); } }
                    else { dst = QKV + row * QKVW + c; const float sc = is_qcol(c) ? C2 : 1.0f; v0 = v0 * sc; v1 = v1 * sc; }
                    u32x4 w; w.x = cvt_pk_bf16(v0[0], v0[1]); w.y = cvt_pk_bf16(v0[2], v0[3]); w.z = cvt_pk_bf16(v1[0], v1[1]); w.w = cvt_pk_bf16(v1[2], v1[3]);
                    *(u32x4*)dst = w; } }
    }
};
struct EpiPlainBf16 {
    static constexpr bool PERM = true, HOOK = false; static constexpr int HK1 = -1, HK2 = -1;
    bf16* O; int ldc;
    __device__ __forceinline__ void hook(Acc&, const Unit&, int, int, int, int, int) const {}
    __device__ __forceinline__ void operator()(const Acc& acc, const Unit& u, int wr, int wc, int fr, int fq) const {
        const int row0 = u.pm * BM + wr * 64 + fr, col0 = u.pn * BM + wc * 32 + 8 * fq;
#pragma unroll
        for (int ai = 0; ai < 2; ++ai)
#pragma unroll
            for (int m = 0; m < 4; ++m) { bf16* rowp = O + (size_t)(row0 + ai * HALF + m * 16) * ldc + col0;
#pragma unroll
                for (int bj = 0; bj < 2; ++bj) { const f32x4 v0 = acc[ai][bj][m][0], v1 = acc[ai][bj][m][1];
                    u32x4 w; w.x = cvt_pk_bf16(v0[0], v0[1]); w.y = cvt_pk_bf16(v0[2], v0[3]); w.z = cvt_pk_bf16(v1[0], v1[1]); w.w = cvt_pk_bf16(v1[2], v1[3]);
                    *(u32x4*)(rowp + bj * HALF) = w; } }
    }
};
struct EpiMerge {
    static constexpr bool PERM = true, HOOK = true; static constexpr int HK1 = 6, HK2 = 12;
    const bf16* GT; bf16* MG;
    __device__ __forceinline__ void hook(Acc& acc, const Unit& u, int t, int wr, int wc, int fr, int fq) const {
        int frl = fr, fql = fq; asm volatile("" : "+v"(frl), "+v"(fql));
        const int row0 = u.pm * BM + wr * 64 + frl, col0 = u.pn * BM + wc * 32 + 8 * fql, bp = (t == HK1) ? 0 : 1024;
#pragma unroll
        for (int ai = 0; ai < 2; ++ai)
#pragma unroll
            for (int m = 0; m < 4; ++m) { const bf16* gp = GT + (size_t)(row0 + ai * HALF + m * 16) * GATEW + bp + col0;
#pragma unroll
                for (int bj = 0; bj < 2; ++bj) { const u32x4 a = *(const u32x4*)(gp + bj * HALF), b = *(const u32x4*)(gp + 1024 + bj * HALF);
                    f32x4 r0, r1;
                    r0[0] = bflo(a.x) * __builtin_amdgcn_rcpf(bflo(b.x)); r0[1] = bfhi(a.x) * __builtin_amdgcn_rcpf(bfhi(b.x)); r0[2] = bflo(a.y) * __builtin_amdgcn_rcpf(bflo(b.y)); r0[3] = bfhi(a.y) * __builtin_amdgcn_rcpf(bfhi(b.y));
                    r1[0] = bflo(a.z) * __builtin_amdgcn_rcpf(bflo(b.z)); r1[1] = bfhi(a.z) * __builtin_amdgcn_rcpf(bfhi(b.z)); r1[2] = bflo(a.w) * __builtin_amdgcn_rcpf(bflo(b.w)); r1[3] = bfhi(a.w) * __builtin_amdgcn_rcpf(bfhi(b.w));
                    acc[ai][bj][m][0] = acc[ai][bj][m][0] * r0; acc[ai][bj][m][1] = acc[ai][bj][m][1] * r1; }
                asm volatile("" : "+v"(acc[ai][0][m][0]), "+v"(acc[ai][0][m][1]), "+v"(acc[ai][1][m][0]), "+v"(acc[ai][1][m][1]) :: "memory"); }
    }
    __device__ __forceinline__ void operator()(const Acc& acc, const Unit& u, int wr, int wc, int fr, int fq) const {
        const int row0 = u.pm * BM + wr * 64 + fr, col0 = u.pn * BM + wc * 32 + 8 * fq;
#pragma unroll
        for (int ai = 0; ai < 2; ++ai)
#pragma unroll
            for (int m = 0; m < 4; ++m) { const size_t row = (size_t)(row0 + ai * HALF + m * 16); const bf16* gp = GT + row * GATEW + 2048 + col0;
#pragma unroll
                for (int bj = 0; bj < 2; ++bj) { const u32x4 a = *(const u32x4*)(gp + bj * HALF); const f32x4 v0 = acc[ai][bj][m][0], v1 = acc[ai][bj][m][1];
                    u32x4 w; w.x = cvt_pk_bf16(v0[0] * bflo(a.x), v0[1] * bfhi(a.x)); w.y = cvt_pk_bf16(v0[2] * bflo(a.y), v0[3] * bfhi(a.y));
                    w.z = cvt_pk_bf16(v1[0] * bflo(a.z), v1[1] * bfhi(a.z)); w.w = cvt_pk_bf16(v1[2] * bflo(a.w), v1[3] * bfhi(a.w));
                    *(u32x4*)(MG + row * DM + col0 + bj * HALF) = w; } }
    }
};
struct EpiOut {
    static constexpr bool PERM = false, HOOK = false; static constexpr int HK1 = -1, HK2 = -1;
    const float* X; float* O;
    __device__ __forceinline__ void hook(Acc&, const Unit&, int, int, int, int, int) const {}
    __device__ __forceinline__ void operator()(const Acc& acc, const Unit& u, int wr, int wc, int fr, int fq) const {
        const int row0 = u.pm * BM + wr * 64 + fr, col0 = u.pn * BM + wc * 32 + 4 * fq;
#pragma unroll
        for (int ai = 0; ai < 2; ++ai)
#pragma unroll
            for (int m = 0; m < 4; ++m) { const size_t off = (size_t)(row0 + ai * HALF + m * 16) * DM + col0;
#pragma unroll
                for (int bj = 0; bj < 2; ++bj)
#pragma unroll
                    for (int n = 0; n < 2; ++n) { const f32x4 xv = *(const f32x4*)(X + off + bj * HALF + n * 16); *(f32x4*)(O + off + bj * HALF + n * 16) = xv * ALPHA + acc[ai][bj][m][n]; } }
    }
};
}

__device__ __forceinline__ float sigmoid_clamped(float v) { const float s = __builtin_amdgcn_rcpf(1.0f + fast_exp2(-v * LOG2E)); return fmaxf(s, 1e-18f); }
__device__ __forceinline__ bool is_qcol(int c) { return c < C_KA || (c >= C_QB && c < C_KB) || c >= C_QM; }
__device__ __forceinline__ void p1_proj_simple(Frame& F, const Args& A) {
    const bf16* XB = (const bf16*)(F.ws + WS_XB); const bf16* WIN = (const bf16*)(F.ws + WS_WIN);
    bf16* QKV = (bf16*)(F.ws + WS_QKV); bf16* GT = (bf16*)(F.ws + WS_GATES);
    sg_phase(F, NTOK / 32, PROJW / 32, DM,
        [&](int r) { return XB + (size_t)r * DM; }, [&](int c) { return WIN + (size_t)c * DM; },
        [&](int row, int col, float v) {
            if (col < QKVW) QKV[(size_t)row * QKVW + col] = (bf16)f2bf(is_qcol(col) ? v * C2 : v);
            else GT[(size_t)row * GATEW + (col - QKVW)] = (bf16)f2bf(sigmoid_clamped(v)); });
    const bf16* MB = (const bf16*)(F.ws + WS_MEMB); const bf16* WM = (const bf16*)(F.ws + WS_WMKV); bf16* MKV = (bf16*)(F.ws + WS_MEMKV);
    sg_phase(F, BATCH * NMEM / 32, 512 / 32, DM,
        [&](int r) { return MB + (size_t)r * DM; }, [&](int c) { return WM + (size_t)c * DM; },
        [&](int row, int col, float v) { MKV[(size_t)row * 512 + col] = (bf16)f2bf(v); });
}
__device__ __forceinline__ void p1b_kmean(Frame& F, const Args& A) {
    const bf16* QKV = (const bf16*)(F.ws + WS_QKV); float* KM = (float*)(F.ws + WS_KMEAN);
    for (int u = F.bid; u < BATCH * NBLK; u += F.G) {
        if (F.tid < 384) { const bf16* p = QKV + (size_t)u * 256 * QKVW + C_KA + F.tid; float s = 0.f;
            for (int r = 0; r < 256; ++r) s += bf2f(p[(size_t)r * QKVW]);
            KM[u * 384 + F.tid] = s * (1.0f / 256.0f); }
    }
}

struct RowAcc {
    float m, l; float o[64];
    __device__ __forceinline__ void init() { m = NEGBIG; l = 0.f;
#pragma unroll
        for (int d = 0; d < 64; ++d) o[d] = 0.f; }
    __device__ __forceinline__ void add(float s, const bf16* vrow) {
        if (s > m) { const float f = fast_exp2(m - s); l *= f;
#pragma unroll
            for (int d = 0; d < 64; ++d) o[d] *= f;
            m = s; }
        const float p = fast_exp2(s - m); l += p;
#pragma unroll
        for (int c = 0; c < 8; ++c) { const u32x4 w = *(const u32x4*)(vrow + 8 * c);
            o[8 * c + 0] += p * bflo(w.x); o[8 * c + 1] += p * bfhi(w.x); o[8 * c + 2] += p * bflo(w.y); o[8 * c + 3] += p * bfhi(w.y);
            o[8 * c + 4] += p * bflo(w.z); o[8 * c + 5] += p * bfhi(w.z); o[8 * c + 6] += p * bflo(w.w); o[8 * c + 7] += p * bfhi(w.w); }
    }
    __device__ __forceinline__ void finish(bf16* yrow, int lane) {
        const float M = wave_max(m); const float w = fast_exp2(m - M); const float L = wave_sum(l * w);
        float mine = 0.f;
#pragma unroll
        for (int d = 0; d < 64; ++d) { const float v = wave_sum(o[d] * w); if (lane == d) mine = v; }
        yrow[lane] = (bf16)f2bf(mine / L);
    }
};
__device__ __forceinline__ float dot64(const u32x4 (&q)[8], const bf16* krow) {
    float s = 0.f;
#pragma unroll
    for (int c = 0; c < 8; ++c) { const u32x4 w = *(const u32x4*)(krow + 8 * c);
        s += bflo(q[c].x) * bflo(w.x) + bfhi(q[c].x) * bfhi(w.x) + bflo(q[c].y) * bflo(w.y) + bfhi(q[c].y) * bfhi(w.y)
           + bflo(q[c].z) * bflo(w.z) + bfhi(q[c].z) * bfhi(w.z) + bflo(q[c].w) * bflo(w.w) + bfhi(q[c].w) * bfhi(w.w); }
    return s;
}
__device__ __forceinline__ void p2_attn_simple(Frame& F, const Args& A) {
    const bf16* QKV = (const bf16*)(F.ws + WS_QKV); bf16* Y = (bf16*)(F.ws + WS_YATT);
    const float* KM = (const float*)(F.ws + WS_KMEAN); const bf16* MKV = (const bf16*)(F.ws + WS_MEMKV);
    const float* relb = A.in[I_RELB];
    const int gw = F.bid * NWAVES + F.wave, NGW = F.G * NWAVES, lane = F.lane;
    constexpr int NHALL = NH_A + NH_B + NH_M;
    for (int task = gw; task < NTOK * NHALL; task += NGW) {
        const int hh = task % NHALL, tok = task / NHALL, b = tok / SEQ, t = tok % SEQ;
        u32x4 q[8];
        if (hh < NH_A) {
            const int h = hh, own = t >> 8;
            const bf16* qp = QKV + (size_t)tok * QKVW + C_QA + h * 64;
#pragma unroll
            for (int c = 0; c < 8; ++c) q[c] = *(const u32x4*)(qp + 8 * c);
            float g = NEGBIG;
            if (lane < own) { const float* km = KM + (size_t)(b * NBLK + lane) * 384 + h * 64; g = 0.f;
#pragma unroll
                for (int c = 0; c < 8; ++c) { g += bflo(q[c].x) * km[8 * c] + bfhi(q[c].x) * km[8 * c + 1] + bflo(q[c].y) * km[8 * c + 2] + bfhi(q[c].y) * km[8 * c + 3]
                                                 + bflo(q[c].z) * km[8 * c + 4] + bfhi(q[c].z) * km[8 * c + 5] + bflo(q[c].w) * km[8 * c + 6] + bfhi(q[c].w) * km[8 * c + 7]; } }
            int s1 = -1, s2 = -1, s3 = -1;
#pragma unroll
            for (int r = 0; r < 3; ++r) { if (r < own) { const float mx = wave_max(g); const unsigned long long bal = __ballot(g == mx); const int idx = __ffsll((long long)bal) - 1;
                if (r == 0) s1 = idx; else if (r == 1) s2 = idx; else s3 = idx; if (lane == idx) g = -3.0e38f; } }
            RowAcc A; A.init();
#pragma unroll
            for (int si = 0; si < 4; ++si) { const int blk = si == 0 ? own : (si == 1 ? s1 : (si == 2 ? s2 : s3)); if (blk < 0) continue;
                for (int c = 0; c < 4; ++c) { const int kpos = blk * 256 + c * 64 + lane; const int rel = t - kpos;
                    if (rel < 0) continue;
                    const bf16* kr = QKV + (size_t)(b * SEQ + kpos) * QKVW + C_KA + h * 64;
                    const float s = dot64(q, kr) + relb[t5_bucket(rel) * NH_A + h] * LOG2E;
                    A.add(s, QKV + (size_t)(b * SEQ + kpos) * QKVW + C_VA + h * 64); } }
            A.finish(Y + (size_t)tok * DM + h * 64, lane);
        } else if (hh < NH_A + NH_B) {
            const int h = hh - NH_A;
            const bf16* qp = QKV + (size_t)tok * QKVW + C_QB + h * 64;
#pragma unroll
            for (int c = 0; c < 8; ++c) q[c] = *(const u32x4*)(qp + 8 * c);
            float o[64];
#pragma unroll
            for (int d = 0; d < 64; ++d) o[d] = 0.f;
            float carry = 0.f;
            for (int base = t - 1; base >= 0; base -= 64) {
                const int s = base - lane; const bool valid = s >= 0;
                float z = 0.f, lk = 0.f, sp = 0.f;
                if (valid) { z = dot64(q, QKV + (size_t)(b * SEQ + s) * QKVW + C_KB + h * 64);
                    sp = fmaxf(z, 0.f) + fast_log2(1.0f + fast_exp2(-fabsf(z))); lk = -sp; }
                float pre = lk;
#pragma unroll
                for (int off = 1; off < 64; off <<= 1) { const float v = __shfl_up(pre, off); if (lane >= off) pre += v; }
                const float E = carry + pre - lk;
                if (valid) { const float a = fast_exp2(z - sp + E); const bf16* vr = QKV + (size_t)(b * SEQ + s) * QKVW + C_VB + h * 64;
#pragma unroll
                    for (int c = 0; c < 8; ++c) { const u32x4 w = *(const u32x4*)(vr + 8 * c);
                        o[8 * c + 0] += a * bflo(w.x); o[8 * c + 1] += a * bfhi(w.x); o[8 * c + 2] += a * bflo(w.y); o[8 * c + 3] += a * bfhi(w.y);
                        o[8 * c + 4] += a * bflo(w.z); o[8 * c + 5] += a * bfhi(w.z); o[8 * c + 6] += a * bflo(w.w); o[8 * c + 7] += a * bfhi(w.w); } }
                carry += __shfl(pre, 63);
                if (carry < -150.0f) break;
            }
            float mine = 0.f;
#pragma unroll
            for (int d = 0; d < 64; ++d) { const float v = wave_sum(o[d]); if (lane == d) mine = v; }
            Y[(size_t)tok * DM + 384 + h * 64 + lane] = (bf16)f2bf(mine);
        } else {
            const int h = hh - NH_A - NH_B;
            const bf16* qp = QKV + (size_t)tok * QKVW + C_QM + h * 64;
#pragma unroll
            for (int c = 0; c < 8; ++c) q[c] = *(const u32x4*)(qp + 8 * c);
            RowAcc A; A.init();
            for (int c = 0; c < 4; ++c) { const bf16* kr = MKV + (size_t)(b * NMEM + c * 64 + lane) * 512 + h * 64;
                A.add(dot64(q, kr), kr + 256); }
            A.finish(Y + (size_t)tok * DM + 768 + h * 64, lane);
        }
    }
}


namespace fa {
typedef short s16x4 __attribute__((ext_vector_type(4)));
typedef short v4i16_t __attribute__((ext_vector_type(4)));
typedef const LAS unsigned char* lcp;
__device__ __forceinline__ s16x4 vtr(lcp p) { return __builtin_bit_cast(s16x4, __builtin_amdgcn_ds_read_tr16_b64_v4i16((LAS v4i16_t*)p)); }
#define FA_MFMA(a, b, c) __builtin_amdgcn_mfma_f32_32x32x16_bf16((a), (b), (c), 0, 0, 0)
__device__ __forceinline__ unsigned cvtpk(float lo, float hi) { f32x2 v = {lo, hi}; typedef __bf16 bf2 __attribute__((ext_vector_type(2))); bf2 b = __builtin_convertvector(v, bf2); return __builtin_bit_cast(unsigned, b); }
__device__ __forceinline__ bf16x8 pack8(const f32x16& p, int s8) {
    u32x4 w; w.x = cvtpk(p[s8], p[s8 + 1]); w.y = cvtpk(p[s8 + 2], p[s8 + 3]); w.z = cvtpk(p[s8 + 4], p[s8 + 5]); w.w = cvtpk(p[s8 + 6], p[s8 + 7]); return __builtin_bit_cast(bf16x8, w); }
__device__ __forceinline__ float max16(const f32x16& p) { float a = fmaxf(fmaxf(p[0], p[1]), fmaxf(p[2], p[3])), b = fmaxf(fmaxf(p[4], p[5]), fmaxf(p[6], p[7]));
    float c = fmaxf(fmaxf(p[8], p[9]), fmaxf(p[10], p[11])), d = fmaxf(fmaxf(p[12], p[13]), fmaxf(p[14], p[15])); return fmaxf(fmaxf(a, b), fmaxf(c, d)); }
__device__ __forceinline__ float sum16(const f32x16& p) { return ((p[0] + p[1]) + (p[2] + p[3])) + ((p[4] + p[5]) + (p[6] + p[7])) + (((p[8] + p[9]) + (p[10] + p[11])) + ((p[12] + p[13]) + (p[14] + p[15]))); }

constexpr int L_K = 0, L_V = 16384, L_WS = 32768, L_TBL = 34816, L_KM = 35328, L_END = 39424;
constexpr float THR = 8.0f;

template <bool MEM>
__device__ __forceinline__ void softmax_unit(Frame& F, const Args& A, int b, int h, int qb) {
    const int tid = F.tid, lane = F.lane, r32 = lane & 31, hi = lane >> 5, wid = F.wave;
    LAS unsigned char* L = F.lds;
    const bf16* QKV = (const bf16*)(F.ws + WS_QKV) + (size_t)b * SEQ * QKVW;
    const bf16* Qp = QKV + (MEM ? C_QM : C_QA) + h * 64;
    const int kvp = MEM ? 512 : QKVW;
    const bf16* Kp = MEM ? (const bf16*)(F.ws + WS_MEMKV) + (size_t)b * NMEM * 512 + h * 64 : QKV + C_KA + h * 64;
    const bf16* Vp = MEM ? Kp + 256 : QKV + C_VA + h * 64;
    const int q0 = qb * 256, qw0 = q0 + wid * 32, qpos = qw0 + r32, own = qb;
    bf16x8 qr[4];
#pragma unroll
    for (int d0 = 0; d0 < 4; ++d0) qr[d0] = *(const bf16x8*)(Qp + (size_t)qpos * QKVW + d0 * 16 + hi * 8);
    LAS float* wsf = (LAS float*)(L + L_WS) + wid * 64;
    LAS float* tbl = (LAS float*)(L + L_TBL);
    LAS float* km = (LAS float*)(L + L_KM);
    const bf16* ksrc = Kp + (size_t)lane * kvp + wid * 8;
    const bf16* vsrc = Vp + (size_t)(16 * (wid & 3) + (lane >> 2)) * kvp + (wid >> 2) * 32 + (lane & 3) * 8;
#define FA_DMA(k0_, slot_) do { \
        __builtin_amdgcn_global_load_lds((const unsigned*)(ksrc + (size_t)(k0_) * kvp), (LAS unsigned*)(L + L_K + (slot_) * 8192 + wid * 1024), 16, 0, 0); \
        __builtin_amdgcn_global_load_lds((const unsigned*)(vsrc + (size_t)(k0_) * kvp), (LAS unsigned*)(L + L_V + (slot_) * 8192 + wid * 1024), 16, 0, 0); } while (0)
    const int NT = MEM ? 4 : 4 * (own + 1);
#define FA_K0(t_) (MEM ? 64 * (t_) : ((t_) < 4 ? own * 256 + 64 * (t_) : (own - 1 - (((t_) - 4) >> 2)) * 256 + 64 * (((t_) - 4) & 3)))
    unsigned selmask = 0u; float bias31 = 0.f;
    if constexpr (!MEM) {
        if (tid < 128) tbl[tid] = A.in[I_RELB][t5_bucket(tid) * NH_A + h] * LOG2E;
        const float* KM = (const float*)(F.ws + WS_KMEAN) + (size_t)(b * NBLK) * 512 + 128 + h * 64;
        for (int i = tid; i < own * 64; i += NTHREADS) km[i] = KM[(size_t)(i >> 6) * 512 + (i & 63)] * (1.0f / 256.0f);
    }
    FA_DMA(FA_K0(0), 0);
    if constexpr (!MEM) {
        __syncthreads();
        bias31 = tbl[127];
        float qf[32];
#pragma unroll
        for (int d0 = 0; d0 < 4; ++d0) { const u32x4 w = __builtin_bit_cast(u32x4, qr[d0]);
            qf[8 * d0 + 0] = bflo(w.x); qf[8 * d0 + 1] = bfhi(w.x); qf[8 * d0 + 2] = bflo(w.y); qf[8 * d0 + 3] = bfhi(w.y); qf[8 * d0 + 4] = bflo(w.z); qf[8 * d0 + 5] = bfhi(w.z); qf[8 * d0 + 6] = bflo(w.w); qf[8 * d0 + 7] = bfhi(w.w); }
        float g[15];
#pragma unroll
        for (int j = 0; j < 15; ++j) { g[j] = NEGBIG;
            if (j < own) { float sacc = 0.f;
#pragma unroll
                for (int d0 = 0; d0 < 4; ++d0) { const f32x4 k0v = *(const LAS f32x4*)(km + j * 64 + d0 * 16 + hi * 8), k1v = *(const LAS f32x4*)(km + j * 64 + d0 * 16 + hi * 8 + 4);
                    sacc += (qf[8 * d0] * k0v.x + qf[8 * d0 + 1] * k0v.y) + (qf[8 * d0 + 2] * k0v.z + qf[8 * d0 + 3] * k0v.w) + (qf[8 * d0 + 4] * k1v.x + qf[8 * d0 + 5] * k1v.y) + (qf[8 * d0 + 6] * k1v.z + qf[8 * d0 + 7] * k1v.w); }
                g[j] = sacc + __shfl_xor(sacc, 32); } }
        if (own <= 3) selmask = (1u << own) - 1u;
        else {
#pragma unroll
            for (int r = 0; r < 3; ++r) { float best = -3.0e38f; int bi = 0;
#pragma unroll
                for (int j = 0; j < 15; ++j) { const bool c = (j < own) && !((selmask >> j) & 1u) && (g[j] > best); best = c ? g[j] : best; bi = c ? j : bi; }
                selmask |= 1u << bi; }
        }
    }
    float m = NEGBIG, l = 0.f;
    f32x16 o[2]; o[0] = f32x16{}; o[1] = f32x16{};
    const lcp kp0 = (lcp)L + L_K + hi * 1024 + r32 * 16;
    const lcp vp0 = (lcp)L + L_V + ((lane >> 4) & 1) * 32 + (lane & 3) * 8 + (4 * hi + ((lane & 15) >> 2)) * 64;
    for (int t = 0; t < NT; ++t) {
        asm volatile("s_waitcnt vmcnt(0)" ::: "memory");
        __syncthreads();
        if (t + 1 < NT) FA_DMA(FA_K0(t + 1), (t + 1) & 1);
        const int k0 = FA_K0(t), blk = MEM ? 0 : (k0 >> 8);
        if (!MEM && blk == own && k0 > qw0 + 31) continue;
        const lcp kp = kp0 + (t & 1) * 8192; const lcp vp = vp0 + (t & 1) * 8192;
        f32x16 p0 = f32x16{}, p1 = f32x16{};
#pragma unroll
        for (int d0 = 0; d0 < 4; ++d0) { const bf16x8 ka = *(const LAS bf16x8*)(kp + d0 * 2048), kb = *(const LAS bf16x8*)(kp + d0 * 2048 + 512);
            p0 = FA_MFMA(ka, qr[d0], p0); p1 = FA_MFMA(kb, qr[d0], p1); }
        if constexpr (!MEM) {
            const bool sel = (blk == own) || ((selmask >> blk) & 1u);
            if (qw0 - (k0 + 63) < 113) {
#pragma unroll
                for (int i = 0; i < 16; ++i) { const int rel0 = qpos - (k0 + crow(i, hi)), rel1 = rel0 - 32;
                    const float b0 = tbl[rel0 < 0 ? 0 : (rel0 > 127 ? 127 : rel0)], b1 = tbl[rel1 < 0 ? 0 : (rel1 > 127 ? 127 : rel1)];
                    p0[i] = (sel && rel0 >= 0) ? p0[i] + b0 : NEGBIG; p1[i] = (sel && rel1 >= 0) ? p1[i] + b1 : NEGBIG; }
            } else { const float pen = sel ? bias31 : NEGBIG;
#pragma unroll
                for (int i = 0; i < 16; ++i) { p0[i] = sel ? p0[i] + pen : NEGBIG; p1[i] = sel ? p1[i] + pen : NEGBIG; } }
        }
        float rm = fmaxf(max16(p0), max16(p1)); rm = fmaxf(rm, __shfl_xor(rm, 32));
        if (__any(rm > m + THR)) {
            const float mn = fmaxf(m, rm), al = fast_exp2(m - mn); l *= al; m = mn;
            if (hi == 0) wsf[r32] = al;
            asm volatile("s_waitcnt lgkmcnt(0)" ::: "memory");
#pragma unroll
            for (int i = 0; i < 16; ++i) { const float a_ = wsf[crow(i, hi)]; o[0][i] *= a_; o[1][i] *= a_; }
        }
#pragma unroll
        for (int i = 0; i < 16; ++i) { p0[i] = fast_exp2(p0[i] - m); p1[i] = fast_exp2(p1[i] - m); }
        l += sum16(p0) + sum16(p1);
        const bf16x8 pa0 = pack8(p0, 0), pa1 = pack8(p0, 8), pa2 = pack8(p1, 0), pa3 = pack8(p1, 8);
#pragma unroll
        for (int d0 = 0; d0 < 2; ++d0) {
            s16x4 lo[4], hh[4];
#pragma unroll
            for (int ks = 0; ks < 4; ++ks) { lo[ks] = vtr(vp + d0 * 4096 + ks * 1024); hh[ks] = vtr(vp + d0 * 4096 + ks * 1024 + 512); }
#define FA_VF(k) (bf16x8){lo[k][0], lo[k][1], lo[k][2], lo[k][3], hh[k][0], hh[k][1], hh[k][2], hh[k][3]}
            o[d0] = FA_MFMA(pa0, FA_VF(0), o[d0]); o[d0] = FA_MFMA(pa1, FA_VF(1), o[d0]); o[d0] = FA_MFMA(pa2, FA_VF(2), o[d0]); o[d0] = FA_MFMA(pa3, FA_VF(3), o[d0]);
        }
    }
    l += __shfl_xor(l, 32);
    if (hi == 0) wsf[r32] = 1.0f / l;
    asm volatile("s_waitcnt lgkmcnt(0)" ::: "memory");
    bf16* Y = (bf16*)(F.ws + WS_YATT) + (size_t)(b * SEQ + qw0) * DM + (MEM ? 768 : 0) + h * 64 + r32;
#pragma unroll
    for (int i = 0; i < 16; ++i) { const float inv = wsf[crow(i, hi)]; bf16* yr = Y + (size_t)crow(i, hi) * DM;
        yr[0] = (bf16)f2bf(o[0][i] * inv); yr[32] = (bf16)f2bf(o[1][i] * inv); }
#undef FA_DMA
#undef FA_K0
}

__device__ __forceinline__ void sb_unit(Frame& F, const Args& A, int b, int h, int qb) {
    const int lane = F.lane, r32 = lane & 31, hi = lane >> 5, wid = F.wave;
    LAS unsigned char* L = F.lds + wid * 16384;
    const bf16* QKV = (const bf16*)(F.ws + WS_QKV) + (size_t)b * SEQ * QKVW;
    const bf16* Qp = QKV + C_QB + h * 64; const bf16* Kp = QKV + C_KB + h * 64; const bf16* Vp = QKV + C_VB + h * 64;
    const int qw0 = qb * 256 + wid * 32, qpos = qw0 + r32;
    bf16x8 qr[4];
#pragma unroll
    for (int d0 = 0; d0 < 4; ++d0) qr[d0] = *(const bf16x8*)(Qp + (size_t)qpos * QKVW + d0 * 16 + hi * 8);
    const bf16* kbase = Kp + (size_t)r32 * QKVW + hi * 8;
    const bf16* vsrc = Vp + (size_t)(lane >> 2) * QKVW + (lane & 3) * 8;
    const lcp vp0 = (lcp)L + ((lane >> 4) & 1) * 32 + (lane & 3) * 8 + (4 * hi + ((lane & 15) >> 2)) * 64;
    bf16x8 kf[8];
#define SB_LOADK(k0_) do { _Pragma("unroll") for (int d0 = 0; d0 < 4; ++d0) { kf[2 * d0] = *(const bf16x8*)(kbase + (size_t)(k0_) * QKVW + d0 * 16); kf[2 * d0 + 1] = *(const bf16x8*)(kbase + (size_t)((k0_) + 32) * QKVW + d0 * 16); } } while (0)
#define SB_DMAV(k0_, slot_) do { _Pragma("unroll") for (int w = 0; w < 8; ++w) \
        __builtin_amdgcn_global_load_lds((const unsigned*)(vsrc + (size_t)((k0_) + 16 * (w & 3)) * QKVW + (w >> 2) * 32), (LAS unsigned*)(L + (slot_) * 8192 + w * 1024), 16, 0, 0); } while (0)
    int k0 = (qw0 >> 6) << 6, slot = 0; bool first = true;
    SB_LOADK(k0); SB_DMAV(k0, 0);
    float carry = 0.f;
    f32x16 o[2]; o[0] = f32x16{}; o[1] = f32x16{};
    for (;;) {
        asm volatile("s_waitcnt vmcnt(0)" ::: "memory");
        f32x16 p0 = f32x16{}, p1 = f32x16{};
#pragma unroll
        for (int d0 = 0; d0 < 4; ++d0) { p0 = FA_MFMA(kf[2 * d0], qr[d0], p0); p1 = FA_MFMA(kf[2 * d0 + 1], qr[d0], p1); }
        const int k0n = k0 - 64;
        if (k0n >= 0) { SB_LOADK(k0n); SB_DMAV(k0n, slot ^ 1); }
        f32x16 lk0, lk1;
#pragma unroll
        for (int i = 0; i < 16; ++i) {
            const float z0 = p0[i], z1 = p1[i];
            const float sp0 = fmaxf(z0, 0.f) + fast_log2(1.0f + fast_exp2(-fabsf(z0))), sp1 = fmaxf(z1, 0.f) + fast_log2(1.0f + fast_exp2(-fabsf(z1)));
            const bool v0 = !first || (k0 + crow(i, hi) < qpos), v1 = !first || (k0 + 32 + crow(i, hi) < qpos);
            lk0[i] = v0 ? -sp0 : 0.f; lk1[i] = v1 ? -sp1 : 0.f;
            p0[i] = v0 ? z0 - sp0 : NEGBIG; p1[i] = v1 ? z1 - sp1 : NEGBIG;
        }
        float gs[8], pg[8], T[8];
#pragma unroll
        for (int q = 0; q < 4; ++q) { gs[q] = (lk0[4 * q] + lk0[4 * q + 1]) + (lk0[4 * q + 2] + lk0[4 * q + 3]); gs[4 + q] = (lk1[4 * q] + lk1[4 * q + 1]) + (lk1[4 * q + 2] + lk1[4 * q + 3]); }
#pragma unroll
        for (int e = 0; e < 8; ++e) pg[e] = __shfl_xor(gs[e], 32);
        T[7] = 0.f;
#pragma unroll
        for (int e = 6; e >= 0; --e) T[e] = T[e + 1] + (gs[e + 1] + pg[e + 1]);
        const float total = T[0] + (gs[0] + pg[0]);
#pragma unroll
        for (int e = 0; e < 8; ++e) {
            const float base = carry + T[e] + (hi == 0 ? pg[e] : 0.f);
            if (e < 4) { const int q = e; const float e3 = base, e2 = e3 + lk0[4 * q + 3], e1 = e2 + lk0[4 * q + 2], e0 = e1 + lk0[4 * q + 1];
                p0[4 * q] = fast_exp2(p0[4 * q] + e0); p0[4 * q + 1] = fast_exp2(p0[4 * q + 1] + e1); p0[4 * q + 2] = fast_exp2(p0[4 * q + 2] + e2); p0[4 * q + 3] = fast_exp2(p0[4 * q + 3] + e3); }
            else { const int q = e - 4; const float e3 = base, e2 = e3 + lk1[4 * q + 3], e1 = e2 + lk1[4 * q + 2], e0 = e1 + lk1[4 * q + 1];
                p1[4 * q] = fast_exp2(p1[4 * q] + e0); p1[4 * q + 1] = fast_exp2(p1[4 * q + 1] + e1); p1[4 * q + 2] = fast_exp2(p1[4 * q + 2] + e2); p1[4 * q + 3] = fast_exp2(p1[4 * q + 3] + e3); }
        }
        carry += total;
        const bf16x8 pa0 = pack8(p0, 0), pa1 = pack8(p0, 8), pa2 = pack8(p1, 0), pa3 = pack8(p1, 8);
        const lcp vp = vp0 + slot * 8192;
#pragma unroll
        for (int d0 = 0; d0 < 2; ++d0) {
            s16x4 lo[4], hh[4];
#pragma unroll
            for (int ks = 0; ks < 4; ++ks) { lo[ks] = vtr(vp + d0 * 4096 + ks * 1024); hh[ks] = vtr(vp + d0 * 4096 + ks * 1024 + 512); }
            o[d0] = FA_MFMA(pa0, FA_VF(0), o[d0]); o[d0] = FA_MFMA(pa1, FA_VF(1), o[d0]); o[d0] = FA_MFMA(pa2, FA_VF(2), o[d0]); o[d0] = FA_MFMA(pa3, FA_VF(3), o[d0]);
        }
        if (k0n < 0 || __all(carry < -150.0f)) break;
        k0 = k0n; slot ^= 1; first = false;
    }
    asm volatile("s_waitcnt vmcnt(0)" ::: "memory");
    bf16* Y = (bf16*)(F.ws + WS_YATT) + (size_t)(b * SEQ + qw0) * DM + 384 + h * 64 + r32;
#pragma unroll
    for (int i = 0; i < 16; ++i) { bf16* yr = Y + (size_t)crow(i, hi) * DM; yr[0] = (bf16)f2bf(o[0][i]); yr[32] = (bf16)f2bf(o[1][i]); }
#undef SB_LOADK
#undef SB_DMAV
#undef FA_VF
}
__device__ __forceinline__ int wq_pop(Frame& F, unsigned* ctr) {
    LAS int* slot = (LAS int*)(F.lds + LDS_MISC + 2048);
    __syncthreads();
    if (F.tid == 0) *slot = (int)__hip_atomic_fetch_add(ctr, 1u, __ATOMIC_RELAXED, __HIP_MEMORY_SCOPE_AGENT);
    __syncthreads();
    return __builtin_amdgcn_readfirstlane(*slot);
}
}
#ifndef REP_A
#define REP_A 1
#endif
#ifndef REP_M
#define REP_M 1
#endif
#ifndef REP_S
#define REP_S 1
#endif
__device__ __forceinline__ void p2_attn_fast(Frame& F, const Args& A, int qoff) {
    const int na = REP_A > 1 ? (A.ph_hi > 0 ? REP_A : 1) : 1, nm = REP_M > 1 ? (A.ph_hi > 0 ? REP_M : 1) : 1, ns = REP_S > 1 ? (A.ph_hi > 0 ? REP_S : 1) : 1;
#pragma unroll 1
    for (int rep = 0; rep < na; ++rep)
    for (;;) { const int u = fa::wq_pop(F, F.ctl + CW_WQ + qoff + rep * 256); if (u >= BATCH * NH_A * NBLK) break;
        const int qb = 15 - u / (BATCH * NH_A), bh = u % (BATCH * NH_A); fa::softmax_unit<false>(F, A, bh / NH_A, bh % NH_A, qb); }
#pragma unroll 1
    for (int rep = 0; rep < nm; ++rep)
    for (;;) { const int u = fa::wq_pop(F, F.ctl + CW_WQ + qoff + 64 + rep * 256); if (u >= BATCH * NH_M * NBLK) break;
        const int qb = u / (BATCH * NH_M), bh = u % (BATCH * NH_M); fa::softmax_unit<true>(F, A, bh / NH_M, bh % NH_M, qb); }
#pragma unroll 1
    for (int rep = 0; rep < ns; ++rep)
    for (;;) { const int u = fa::wq_pop(F, F.ctl + CW_WQ + qoff + 128 + rep * 256); if (u >= BATCH * NH_B * NBLK) break;
        const int qb = u / (BATCH * NH_B), bh = u % (BATCH * NH_B); fa::sb_unit(F, A, bh / NH_B, bh % NH_B, qb); }
}
__device__ __forceinline__ void p3_merge_simple(Frame& F, const Args& A) {
    const bf16* YA = (const bf16*)(F.ws + WS_YATT); const bf16* WBR = (const bf16*)(F.ws + WS_WBR); const bf16* GT = (const bf16*)(F.ws + WS_GATES);
    bf16* MG = (bf16*)(F.ws + WS_MERGED);
    const int gw = F.bid * NWAVES + F.wave, NGW = F.G * NWAVES, r = F.lane & 31, h = F.lane >> 5;
    for (int tile = gw; tile < (NTOK / 32) * (DM / 32); tile += NGW) {
        const int tm = tile / 32, tn = tile % 32;
        const bf16* ap = YA + (size_t)(tm * 32 + r) * DM + 8 * h; const bf16* bp = WBR + (size_t)(tn * 32 + r) * DM + 8 * h;
        f32x16 tot = {};
#pragma unroll 1
        for (int br = 0; br < 3; ++br) { const int k0 = br == 0 ? 0 : (br == 1 ? 384 : 768), k1 = br == 0 ? 384 : (br == 1 ? 768 : 1024);
            f32x16 acc = {};
            for (int k = k0; k < k1; k += 16) acc = __builtin_amdgcn_mfma_f32_32x32x16_bf16(*(const bf16x8*)(ap + k), *(const bf16x8*)(bp + k), acc, 0, 0, 0);
#pragma unroll
            for (int i = 0; i < 16; ++i) tot[i] += acc[i] * bf2f(GT[(size_t)(tm * 32 + crow(i, h)) * GATEW + br * 1024 + tn * 32 + r]); }
#pragma unroll
        for (int i = 0; i < 16; ++i) MG[(size_t)(tm * 32 + crow(i, h)) * DM + tn * 32 + r] = (bf16)f2bf(tot[i]);
    }
}
__device__ __forceinline__ void p4_out_simple(Frame& F, const Args& A) {
    const bf16* MG = (const bf16*)(F.ws + WS_MERGED); const bf16* WO = (const bf16*)(F.ws + WS_WOUT); float* X1 = (float*)(F.ws + WS_X1); const float* x = A.in[I_X];
    sg_phase(F, NTOK / 32, DM / 32, DM,
        [&](int r) { return MG + (size_t)r * DM; }, [&](int c) { return WO + (size_t)c * DM; },
        [&](int row, int col, float v) { X1[(size_t)row * DM + col] = ALPHA * x[(size_t)row * DM + col] + v; });
}

template <bool DRY>
__device__ __forceinline__ void p5_ln_router(Frame& F, const Args& A) {
    LAS float* WR = (LAS float*)F.lds;
    LAS unsigned* lcnt = (LAS unsigned*)(F.lds + LDS_MISC);
    LAS unsigned* lbase = lcnt + 32;
    LAS unsigned* rinfo = lcnt + 64;
    LAS float* rgate = (LAS float*)(lcnt + 64 + 512);
    const float* WRT = (const float*)(F.ws + WS_WRT);
    for (int i = F.tid; i < 36 * 1024 / 4; i += NTHREADS) ((LAS f32x4*)WR)[i] = ((const f32x4*)WRT)[i];
    float* X1 = (float*)(F.ws + WS_X1); bf16* X1B = DRY ? (bf16*)(F.ws + WS_YATT) : (bf16*)(F.ws + WS_X1B); float* X1O = DRY ? F.out : X1;
    int* LIST = (int*)(F.ws + WS_LIST); float* AG = (float*)(F.ws + WS_AGATE);
    unsigned* gcount = F.ctl + CW_GCOUNT;
    const int lane = F.lane;
    f32x4 lg[4], lb[4];
#pragma unroll
    for (int j = 0; j < 4; ++j) { lg[j] = *(const f32x4*)(A.in[I_LN1G] + 4 * lane + 256 * j); lb[j] = *(const f32x4*)(A.in[I_LN1B] + 4 * lane + 256 * j); }
    const float bias_o = lane < 36 ? WRT[36 * 1024 + lane] : 0.f;
    for (int batch = F.bid; batch < NTOK / 128; batch += F.G) {
        __syncthreads();
        if (F.tid < 32) lcnt[F.tid] = 0u;
        __syncthreads();
        for (int g4 = 0; g4 < 4; ++g4) {
            const int lrow0 = F.wave * 16 + g4 * 4, row0 = batch * 128 + lrow0;
            f32x4 v[4][4];
#pragma unroll
            for (int rr = 0; rr < 4; ++rr) {
                float* xr = X1 + (size_t)(row0 + rr) * DM + 4 * lane; float s = 0.f;
#pragma unroll
                for (int j = 0; j < 4; ++j) { v[rr][j] = *(const f32x4*)(xr + 256 * j); s += (v[rr][j].x + v[rr][j].y) + (v[rr][j].z + v[rr][j].w); }
                const float mean = wave_sum(s) * (1.0f / DM); float s2 = 0.f;
#pragma unroll
                for (int j = 0; j < 4; ++j) { v[rr][j] = v[rr][j] - mean; s2 += (v[rr][j].x * v[rr][j].x + v[rr][j].y * v[rr][j].y) + (v[rr][j].z * v[rr][j].z + v[rr][j].w * v[rr][j].w); }
                const float rstd = 1.0f / sqrtf(wave_sum(s2) * (1.0f / DM) + LN_EPS);
                bf16* xb = X1B + (size_t)(row0 + rr) * DM + 4 * lane;
#pragma unroll
                for (int j = 0; j < 4; ++j) { v[rr][j] = v[rr][j] * rstd * lg[j] + lb[j]; *(f32x4*)(X1O + (size_t)(row0 + rr) * DM + 4 * lane + 256 * j) = v[rr][j];
                    u32x2 w; w.x = pk2(v[rr][j].x, v[rr][j].y); w.y = pk2(v[rr][j].z, v[rr][j].w); *(u32x2*)(xb + 256 * j) = w; }
            }
            float lo[4] = {0.f, 0.f, 0.f, 0.f};
            for (int o = 0; o < 36; ++o) {
                f32x4 w[4];
#pragma unroll
                for (int j = 0; j < 4; ++j) w[j] = *(const LAS f32x4*)(WR + o * 1024 + 4 * lane + 256 * j);
#pragma unroll
                for (int rr = 0; rr < 4; ++rr) { float p = 0.f;
#pragma unroll
                    for (int j = 0; j < 4; ++j) p += (v[rr][j].x * w[j].x + v[rr][j].y * w[j].y) + (v[rr][j].z * w[j].z + v[rr][j].w * w[j].w);
                    p = wave_sum(p); if (lane == o) lo[rr] = p; }
            }
#pragma unroll
            for (int rr = 0; rr < 4; ++rr) {
                const float lgt = lo[rr] + bias_o;
                const float g0 = __shfl(lgt, 0), g1 = __shfl(lgt, 1), g2 = __shfl(lgt, 2), g3 = __shfl(lgt, 3);
                int gi = 0; float gm = g0; if (g1 > gm) { gm = g1; gi = 1; } if (g2 > gm) { gm = g2; gi = 2; } if (g3 > gm) { gm = g3; gi = 3; }
                const float gden = __expf(g0 - gm) + __expf(g1 - gm) + __expf(g2 - gm) + __expf(g3 - gm);
                const float gp = 1.0f / gden;
                float ev[8];
#pragma unroll
                for (int i = 0; i < 8; ++i) ev[i] = __shfl(lgt, 4 + 8 * gi + i);
                int i1 = 0; float m1 = ev[0];
#pragma unroll
                for (int i = 1; i < 8; ++i) if (ev[i] > m1) { m1 = ev[i]; i1 = i; }
                int i2 = -1; float m2 = -3.0e38f;
#pragma unroll
                for (int i = 0; i < 8; ++i) if (i != i1 && ev[i] > m2) { m2 = ev[i]; i2 = i; }
                const float e2 = __expf(m2 - m1), den = 1.0f + e2;
                const float w1 = gp / den, w2 = gp * e2 / den;
                if (lane == 0) { const int ea = gi * 8 + i1, eb = gi * 8 + i2, lr = lrow0 + rr;
                    const unsigned pa = __hip_atomic_fetch_add(lcnt + ea, 1u, __ATOMIC_RELAXED, __HIP_MEMORY_SCOPE_WORKGROUP), pb = __hip_atomic_fetch_add(lcnt + eb, 1u, __ATOMIC_RELAXED, __HIP_MEMORY_SCOPE_WORKGROUP);
                    rinfo[lr * 4 + 0] = ea; rinfo[lr * 4 + 1] = eb; rinfo[lr * 4 + 2] = pa; rinfo[lr * 4 + 3] = pb; rgate[lr * 2] = w1; rgate[lr * 2 + 1] = w2; }
            }
        }
        __syncthreads();
        if (F.tid < 32) lbase[F.tid] = DRY ? 0u : atomicAdd(gcount + F.tid, lcnt[F.tid]);
        __syncthreads();
        if (!DRY && F.tid < 128) { const int lr = F.tid, tok = batch * 128 + lr;
            const unsigned ea = rinfo[lr * 4], eb = rinfo[lr * 4 + 1], pa = rinfo[lr * 4 + 2], pb = rinfo[lr * 4 + 3];
            LIST[(size_t)ea * NTOK + lbase[ea] + pa] = 2 * tok; LIST[(size_t)eb * NTOK + lbase[eb] + pb] = 2 * tok + 1;
            AG[2 * tok] = rgate[lr * 2]; AG[2 * tok + 1] = rgate[lr * 2 + 1]; }
    }
    __syncthreads();
}


template <bool DRY>
__device__ __forceinline__ void p5_ln_router_mfma(Frame& F, const Args& A) {
    constexpr int ROWB = 2064;
    LAS unsigned char* AH = F.lds; LAS unsigned char* AL = F.lds + 16 * ROWB;
    LAS float* PS = (LAS float*)(F.lds + 32 * ROWB);
    LAS float* LG = PS + 8 * 3 * 256;
    LAS unsigned* lcnt = (LAS unsigned*)(F.lds + LDS_MISC);
    LAS unsigned* lbase = lcnt + 32;
    LAS unsigned* rinfo = lcnt + 64;
    LAS float* rgate = (LAS float*)(lcnt + 64 + 512);
    const float* WRT = (const float*)(F.ws + WS_WRT);
    float* X1 = (float*)(F.ws + WS_X1); bf16* X1B = DRY ? (bf16*)(F.ws + WS_YATT) : (bf16*)(F.ws + WS_X1B); float* X1O = DRY ? F.out : X1;
    int* LIST = (int*)(F.ws + WS_LIST); float* AG = (float*)(F.ws + WS_AGATE);
    unsigned* gcount = F.ctl + CW_GCOUNT;
    const int lane = F.lane, tid = F.tid, wv = F.wave, li = lane & 15, lq = lane >> 4;
    f32x4 lg[4], lb[4];
#pragma unroll
    for (int j = 0; j < 4; ++j) { lg[j] = *(const f32x4*)(A.in[I_LN1G] + 4 * lane + 256 * j); lb[j] = *(const f32x4*)(A.in[I_LN1B] + 4 * lane + 256 * j); }
    bf16x8 bh[4][3], bl[4][3];
    { const bf16* WRB = (const bf16*)(F.ws + WS_WRB);
#pragma unroll
      for (int s_ = 0; s_ < 4; ++s_)
#pragma unroll
          for (int cb = 0; cb < 3; ++cb) { const size_t o = ((size_t)(((wv * 4 + s_) * 3 + cb) * 2) * 64 + lane) * 8; bh[s_][cb] = *(const bf16x8*)(WRB + o); bl[s_][cb] = *(const bf16x8*)(WRB + o + 512); } }
    float rb[3] = {0.f, 0.f, 0.f};
    if (tid < 256) {
#pragma unroll
        for (int cb = 0; cb < 3; ++cb) { const int c = 16 * cb + (tid & 15); rb[cb] = c < 36 ? WRT[36 * 1024 + c] : 0.f; } }
    for (int batch = F.bid; batch < NTOK / 128; batch += F.G) {
        __syncthreads();
        if (tid < 32) lcnt[tid] = 0u;
        for (int sb = 0; sb < 8; ++sb) {
#pragma unroll
            for (int rr = 0; rr < 2; ++rr) {
                const int lr = 2 * wv + rr, row = batch * 128 + sb * 16 + lr;
                const float* xr = X1 + (size_t)row * DM + 4 * lane; f32x4 v[4]; float s = 0.f;
#pragma unroll
                for (int j = 0; j < 4; ++j) { v[j] = *(const f32x4*)(xr + 256 * j); s += (v[j].x + v[j].y) + (v[j].z + v[j].w); }
                const float mean = wave_sum(s) * (1.0f / DM); float s2 = 0.f;
#pragma unroll
                for (int j = 0; j < 4; ++j) { v[j] = v[j] - mean; s2 += (v[j].x * v[j].x + v[j].y * v[j].y) + (v[j].z * v[j].z + v[j].w * v[j].w); }
                const float rstd = 1.0f / sqrtf(wave_sum(s2) * (1.0f / DM) + LN_EPS);
                float* xo = X1O + (size_t)row * DM + 4 * lane; bf16* xb = X1B + (size_t)row * DM + 4 * lane;
#pragma unroll
                for (int j = 0; j < 4; ++j) { const f32x4 y = v[j] * rstd * lg[j] + lb[j]; *(f32x4*)(xo + 256 * j) = y;
                    u32x2 hw; hw.x = mg::cvt_pk_bf16(y.x, y.y); hw.y = mg::cvt_pk_bf16(y.z, y.w); *(u32x2*)(xb + 256 * j) = hw;
                    u32x2 lw; lw.x = mg::cvt_pk_bf16(y.x - bflo(hw.x), y.y - bfhi(hw.x)); lw.y = mg::cvt_pk_bf16(y.z - bflo(hw.y), y.w - bfhi(hw.y));
                    *(LAS u32x2*)(AH + lr * ROWB + 8 * lane + 512 * j) = hw; *(LAS u32x2*)(AL + lr * ROWB + 8 * lane + 512 * j) = lw; }
            }
            __syncthreads();
            f32x4 acc[3] = {(f32x4){0.f, 0.f, 0.f, 0.f}, (f32x4){0.f, 0.f, 0.f, 0.f}, (f32x4){0.f, 0.f, 0.f, 0.f}};
#pragma unroll
            for (int s_ = 0; s_ < 4; ++s_) { const int off = li * ROWB + (wv * 128 + 32 * s_ + 8 * lq) * 2;
                const bf16x8 ah = *(const LAS bf16x8*)(AH + off), al = *(const LAS bf16x8*)(AL + off);
#pragma unroll
                for (int cb = 0; cb < 3; ++cb) { acc[cb] = __builtin_amdgcn_mfma_f32_16x16x32_bf16(ah, bh[s_][cb], acc[cb], 0, 0, 0);
                    acc[cb] = __builtin_amdgcn_mfma_f32_16x16x32_bf16(ah, bl[s_][cb], acc[cb], 0, 0, 0); acc[cb] = __builtin_amdgcn_mfma_f32_16x16x32_bf16(al, bh[s_][cb], acc[cb], 0, 0, 0); } }
#pragma unroll
            for (int cb = 0; cb < 3; ++cb)
#pragma unroll
                for (int e = 0; e < 4; ++e) PS[(wv * 3 + cb) * 256 + (4 * lq + e) * 16 + li] = acc[cb][e];
            __syncthreads();
            if (tid < 256) {
#pragma unroll
                for (int cb = 0; cb < 3; ++cb) { float t = rb[cb];
#pragma unroll
                    for (int w = 0; w < 8; ++w) t += PS[(w * 3 + cb) * 256 + tid];
                    LG[(tid >> 4) * 48 + 16 * cb + (tid & 15)] = t; } }
            __syncthreads();
            if (tid < 16) {
                const LAS float* lgr = LG + tid * 48;
                const float g0 = lgr[0], g1 = lgr[1], g2 = lgr[2], g3 = lgr[3];
                int gi = 0; float gm = g0; if (g1 > gm) { gm = g1; gi = 1; } if (g2 > gm) { gm = g2; gi = 2; } if (g3 > gm) { gm = g3; gi = 3; }
                const float gp = 1.0f / (__expf(g0 - gm) + __expf(g1 - gm) + __expf(g2 - gm) + __expf(g3 - gm));
                float ev[8];
#pragma unroll
                for (int i = 0; i < 8; ++i) ev[i] = lgr[4 + 8 * gi + i];
                int i1 = 0; float m1 = ev[0];
#pragma unroll
                for (int i = 1; i < 8; ++i) if (ev[i] > m1) { m1 = ev[i]; i1 = i; }
                int i2 = -1; float m2 = -3.0e38f;
#pragma unroll
                for (int i = 0; i < 8; ++i) if (i != i1 && ev[i] > m2) { m2 = ev[i]; i2 = i; }
                const float e2 = __expf(m2 - m1), den = 1.0f + e2;
                const int ea = gi * 8 + i1, eb = gi * 8 + i2, lrow = sb * 16 + tid;
                const unsigned pa = __hip_atomic_fetch_add(lcnt + ea, 1u, __ATOMIC_RELAXED, __HIP_MEMORY_SCOPE_WORKGROUP), pb = __hip_atomic_fetch_add(lcnt + eb, 1u, __ATOMIC_RELAXED, __HIP_MEMORY_SCOPE_WORKGROUP);
                rinfo[lrow * 4 + 0] = ea; rinfo[lrow * 4 + 1] = eb; rinfo[lrow * 4 + 2] = pa; rinfo[lrow * 4 + 3] = pb; rgate[lrow * 2] = gp / den; rgate[lrow * 2 + 1] = gp * e2 / den;
            }
        }
        __syncthreads();
        if (tid < 32) lbase[tid] = DRY ? 0u : atomicAdd(gcount + tid, lcnt[tid]);
        __syncthreads();
        if (!DRY && tid < 128) { const int lr = tid, tok = batch * 128 + lr;
            const unsigned ea = rinfo[lr * 4], eb = rinfo[lr * 4 + 1], pa = rinfo[lr * 4 + 2], pb = rinfo[lr * 4 + 3];
            LIST[(size_t)ea * NTOK + lbase[ea] + pa] = 2 * tok; LIST[(size_t)eb * NTOK + lbase[eb] + pb] = 2 * tok + 1;
            AG[2 * tok] = rgate[lr * 2]; AG[2 * tok + 1] = rgate[lr * 2 + 1]; }
    }
    __syncthreads();
}

struct MoeTab { LAS int* tstart; LAS int* cnt; };
__device__ __forceinline__ MoeTab moe_table(Frame& F) {
    MoeTab T; T.tstart = (LAS int*)(F.lds + LDS_MISC + 3072); T.cnt = T.tstart + 40;
    __syncthreads();
    if (F.tid == 0) { int acc = 0; for (int e = 0; e < NEXP; ++e) { const int c = (int)__hip_atomic_load(F.ctl + CW_GCOUNT + e, __ATOMIC_RELAXED, __HIP_MEMORY_SCOPE_AGENT); T.cnt[e] = c; T.tstart[e] = acc; acc += (c + 255) >> 8; } T.tstart[NEXP] = acc; }
    __syncthreads();
    return T;
}
__device__ __forceinline__ int moe_expert_of_tile(const MoeTab& T, int tile) { int e = 0; for (int i = 1; i < NEXP; ++i) if (T.tstart[i] <= tile) e = i; return e; }

__device__ __forceinline__ void p6_moe_up_simple(Frame& F, const Args& A) {
    const MoeTab T = moe_table(F);
    const bf16* X1B = (const bf16*)(F.ws + WS_X1B); const bf16* WGU = (const bf16*)(F.ws + WS_WGU); bf16* H = (bf16*)(F.ws + WS_H); const int* LIST = (const int*)(F.ws + WS_LIST);
    const int gw = F.bid * NWAVES + F.wave, NGW = F.G * NWAVES, r = F.lane & 31, h = F.lane >> 5;
    const int ntile32 = T.tstart[NEXP] * 8;
    for (int w = gw; w < ntile32 * 16; w += NGW) {
        const int t32 = w / 16, cg = w % 16, tile = t32 >> 3, e = moe_expert_of_tile(T, tile), cnt = T.cnt[e];
        int lrow = (tile - T.tstart[e]) * 256 + (t32 & 7) * 32 + r; if (lrow >= cnt) lrow = cnt - 1;
        const int tok = LIST[(size_t)e * NTOK + lrow] >> 1;
        const bf16* ap = X1B + (size_t)tok * DM + 8 * h;
        const int n = cg * 32 + r;
        const bf16* bg = WGU + ((size_t)e * 1024 + (n / 128) * 256 + (n % 128)) * 1024 + 8 * h; const bf16* bu = bg + (size_t)128 * 1024;
        f32x16 ag = {}, au = {};
        for (int k = 0; k < DM; k += 16) { const bf16x8 a = *(const bf16x8*)(ap + k);
            ag = __builtin_amdgcn_mfma_f32_32x32x16_bf16(a, *(const bf16x8*)(bg + k), ag, 0, 0, 0);
            au = __builtin_amdgcn_mfma_f32_32x32x16_bf16(a, *(const bf16x8*)(bu + k), au, 0, 0, 0); }
#pragma unroll
        for (int i = 0; i < 16; ++i) { const float g = ag[i], s = g * __builtin_amdgcn_rcpf(1.0f + fast_exp2(-g * LOG2E));
            H[(size_t)(t32 * 32 + crow(i, h)) * DEXP + n] = (bf16)f2bf(s * au[i]); }
    }
}
__device__ __forceinline__ void p7_moe_down_simple(Frame& F, const Args& A) {
    const MoeTab T = moe_table(F);
    const bf16* H = (const bf16*)(F.ws + WS_H); const bf16* WD = (const bf16*)(F.ws + WS_WD); bf16* Y = (bf16*)(F.ws + WS_Y);
    const int* LIST = (const int*)(F.ws + WS_LIST); const float* AG = (const float*)(F.ws + WS_AGATE);
    const int gw = F.bid * NWAVES + F.wave, NGW = F.G * NWAVES, r = F.lane & 31, h = F.lane >> 5;
    const int ntile32 = T.tstart[NEXP] * 8;
    for (int w = gw; w < ntile32 * 32; w += NGW) {
        const int t32 = w / 32, cg = w % 32, tile = t32 >> 3, e = moe_expert_of_tile(T, tile), cnt = T.cnt[e];
        const bf16* ap = H + (size_t)(t32 * 32 + r) * DEXP + 8 * h;
        const bf16* bp = WD + ((size_t)e * 1024 + cg * 32 + r) * DEXP + 8 * h;
        f32x16 acc = {};
        for (int k = 0; k < DEXP; k += 16) acc = __builtin_amdgcn_mfma_f32_32x32x16_bf16(*(const bf16x8*)(ap + k), *(const bf16x8*)(bp + k), acc, 0, 0, 0);
#pragma unroll
        for (int i = 0; i < 16; ++i) { const int lrow = (tile - T.tstart[e]) * 256 + (t32 & 7) * 32 + crow(i, h);
            if (lrow < cnt) { const int a = LIST[(size_t)e * NTOK + lrow]; Y[(size_t)a * DM + cg * 32 + r] = (bf16)f2bf(acc[i] * AG[a]); } }
    }
}

#ifndef FASTMASK
#define FASTMASK 442
#endif
namespace mg {
struct MoeOrder {
    MoeTab T; const char* A; const char* Bt; size_t a_tile, b_exp, b_tile; const int* LIST; int G, c, ntiles;
    __device__ __forceinline__ bool next(int i, Unit& u) const {
        const int L = i * G + c; if (L >= ntiles * 4) return false;
        const int tile = L >> 2; const int e = __builtin_amdgcn_readfirstlane(moe_expert_of_tile(T, tile));
        u.pm = tile; u.pn = L & 3; u.e = e; u.lt = tile - __builtin_amdgcn_readfirstlane(T.tstart[e]); return true;
    }
    __device__ __forceinline__ const char* a_base(const Unit& u) const { return A + (size_t)u.pm * a_tile; }
    __device__ __forceinline__ const char* b_base(const Unit& u) const { return Bt + (size_t)u.e * b_exp + (size_t)u.pn * b_tile; }
    __device__ __forceinline__ int row(const Unit& u, int r) const { int lrow = u.lt * 256 + r; const int cnt = T.cnt[u.e]; if (lrow >= cnt) lrow = cnt - 1; return LIST[(size_t)u.e * NTOK + lrow] >> 1; }
};
struct EpiMoeUp {
    static constexpr bool PERM = true, HOOK = false; static constexpr int HK1 = -1, HK2 = -1;
    bf16* H;
    __device__ __forceinline__ void hook(Acc&, const Unit&, int, int, int, int, int) const {}
    __device__ __forceinline__ void operator()(const Acc& acc, const Unit& u, int wr, int wc, int fr, int fq) const {
        const int row0 = u.pm * BM + wr * 64 + fr, col0 = u.pn * 128 + wc * 32 + 8 * fq;
#pragma unroll
        for (int ai = 0; ai < 2; ++ai)
#pragma unroll
            for (int m = 0; m < 4; ++m) { f32x4 h0, h1;
#pragma unroll
                for (int j = 0; j < 4; ++j) { const float g0 = acc[ai][0][m][0][j], g1 = acc[ai][0][m][1][j];
                    h0[j] = g0 * __builtin_amdgcn_rcpf(1.0f + fast_exp2(-g0 * LOG2E)) * acc[ai][1][m][0][j]; h1[j] = g1 * __builtin_amdgcn_rcpf(1.0f + fast_exp2(-g1 * LOG2E)) * acc[ai][1][m][1][j]; }
                u32x4 w; w.x = cvt_pk_bf16(h0[0], h0[1]); w.y = cvt_pk_bf16(h0[2], h0[3]); w.z = cvt_pk_bf16(h1[0], h1[1]); w.w = cvt_pk_bf16(h1[2], h1[3]);
                *(u32x4*)(H + (size_t)(row0 + ai * HALF + m * 16) * DEXP + col0) = w; }
    }
};
struct EpiMoeDown {
    static constexpr bool PERM = true, HOOK = false; static constexpr int HK1 = -1, HK2 = -1;
    bf16* Y; const int* LIST; const float* AG; MoeTab T;
    __device__ __forceinline__ void hook(Acc&, const Unit&, int, int, int, int, int) const {}
    __device__ __forceinline__ void operator()(const Acc& acc, const Unit& u, int wr, int wc, int fr, int fq) const {
        const int col0 = u.pn * BM + wc * 32 + 8 * fq, cnt = T.cnt[u.e];
#pragma unroll
        for (int ai = 0; ai < 2; ++ai)
#pragma unroll
            for (int m = 0; m < 4; ++m) { const int lrow = u.lt * 256 + ai * HALF + wr * 64 + m * 16 + fr;
                if (lrow < cnt) { const int a = LIST[(size_t)u.e * NTOK + lrow]; const float g = AG[a];
#pragma unroll
                    for (int bj = 0; bj < 2; ++bj) { const f32x4 v0 = acc[ai][bj][m][0] * g, v1 = acc[ai][bj][m][1] * g;
                        u32x4 w; w.x = cvt_pk_bf16(v0[0], v0[1]); w.y = cvt_pk_bf16(v0[2], v0[3]); w.z = cvt_pk_bf16(v1[0], v1[1]); w.w = cvt_pk_bf16(v1[2], v1[3]);
                        *(u32x4*)(Y + (size_t)a * DM + col0 + bj * HALF) = w; } } }
    }
};
}
__device__ __forceinline__ void p1_proj_fast(Frame& F, const Args& A) {
    { mg::StaticOrder S; S.init(F.ws + WS_XB, F.ws + WS_WIN, DM, DM, NTOK, PROJW, F.G, F.bid);
      mg::EpiProj E{(bf16*)(F.ws + WS_QKV), (bf16*)(F.ws + WS_GATES), (float*)(F.ws + WS_KMEAN)};
      mg::gemm_phase<mg::EpiProj, mg::StaticOrder, false, true>(F.lds, DM, DM, DM, S, E); }
    { mg::StaticOrder S; S.init(F.ws + WS_MEMB, F.ws + WS_WMKV, DM, DM, BATCH * NMEM, 512, F.G, F.bid);
      mg::EpiPlainBf16 E{(bf16*)(F.ws + WS_MEMKV), 512};
      mg::gemm_phase<mg::EpiPlainBf16, mg::StaticOrder, false, false>(F.lds, DM, DM, DM, S, E); }
}
__device__ __forceinline__ void p3_merge_fast(Frame& F, const Args& A) {
    mg::StaticOrder S; S.init(F.ws + WS_YATT, F.ws + WS_WBR, DM, DM, NTOK, DM, F.G, F.bid);
    mg::EpiMerge E{(const bf16*)(F.ws + WS_GATES), (bf16*)(F.ws + WS_MERGED)};
    mg::gemm_phase<mg::EpiMerge, mg::StaticOrder, false, true>(F.lds, DM, DM, DM, S, E);
}
__device__ __forceinline__ void p4_out_fast(Frame& F, const Args& A) {
    mg::StaticOrder S; S.init(F.ws + WS_MERGED, F.ws + WS_WOUT, DM, DM, NTOK, DM, F.G, F.bid);
    mg::EpiOut E{A.in[I_X], (float*)(F.ws + WS_X1)};
    mg::gemm_phase<mg::EpiOut, mg::StaticOrder, false, true>(F.lds, DM, DM, DM, S, E);
}
__device__ __forceinline__ void p6_moe_up_fast(Frame& F, const Args& A) {
    const MoeTab T = moe_table(F);
    mg::MoeOrder S{T, (const char*)(F.ws + WS_X1B), (const char*)(F.ws + WS_WGU), 0, (size_t)1024 * 1024 * 2, (size_t)256 * 1024 * 2, (const int*)(F.ws + WS_LIST), F.G, F.bid, __builtin_amdgcn_readfirstlane(T.tstart[NEXP])};
    mg::EpiMoeUp E{(bf16*)(F.ws + WS_H)};
    mg::gemm_phase<mg::EpiMoeUp, mg::MoeOrder, true, true>(F.lds, DM, DM, DM, S, E);
}
__device__ __forceinline__ void p7_moe_down_fast(Frame& F, const Args& A) {
    const MoeTab T = moe_table(F);
    mg::MoeOrder S{T, (const char*)(F.ws + WS_H), (const char*)(F.ws + WS_WD), (size_t)256 * DEXP * 2, (size_t)1024 * DEXP * 2, (size_t)256 * DEXP * 2, (const int*)(F.ws + WS_LIST), F.G, F.bid, __builtin_amdgcn_readfirstlane(T.tstart[NEXP])};
    mg::EpiMoeDown E{(bf16*)(F.ws + WS_Y), (const int*)(F.ws + WS_LIST), (const float*)(F.ws + WS_AGATE), T};
    mg::gemm_phase<mg::EpiMoeDown, mg::MoeOrder, false, true>(F.lds, DEXP, DEXP, DEXP, S, E);
}

__device__ __forceinline__ void p8_final(Frame& F, const Args& A) {
    const float* X1 = (const float*)(F.ws + WS_X1); const bf16* Y = (const bf16*)(F.ws + WS_Y);
    const int gw = F.bid * NWAVES + F.wave, NGW = F.G * NWAVES, lane = F.lane;
    f32x4 lg[4], lb[4];
#pragma unroll
    for (int j = 0; j < 4; ++j) { lg[j] = *(const f32x4*)(A.in[I_LN2G] + 4 * lane + 256 * j); lb[j] = *(const f32x4*)(A.in[I_LN2B] + 4 * lane + 256 * j); }
    for (int row = gw; row < NTOK; row += NGW) {
        const float* xr = X1 + (size_t)row * DM + 4 * lane; const bf16* y0 = Y + (size_t)(2 * row) * DM + 4 * lane; const bf16* y1 = y0 + DM;
        f32x4 v[4]; float s = 0.f;
#pragma unroll
        for (int j = 0; j < 4; ++j) { const f32x4 x = *(const f32x4*)(xr + 256 * j); const u32x2 a = *(const u32x2*)(y0 + 256 * j), b = *(const u32x2*)(y1 + 256 * j);
            v[j].x = ALPHA * x.x + (bflo(a.x) + bflo(b.x)); v[j].y = ALPHA * x.y + (bfhi(a.x) + bfhi(b.x)); v[j].z = ALPHA * x.z + (bflo(a.y) + bflo(b.y)); v[j].w = ALPHA * x.w + (bfhi(a.y) + bfhi(b.y));
            s += (v[j].x + v[j].y) + (v[j].z + v[j].w); }
        const float mean = wave_sum(s) * (1.0f / DM); float s2 = 0.f;
#pragma unroll
        for (int j = 0; j < 4; ++j) { v[j] = v[j] - mean; s2 += (v[j].x * v[j].x + v[j].y * v[j].y) + (v[j].z * v[j].z + v[j].w * v[j].w); }
        const float rstd = 1.0f / sqrtf(wave_sum(s2) * (1.0f / DM) + LN_EPS);
        float* orow = F.out + (size_t)row * DM + 4 * lane;
#pragma unroll
        for (int j = 0; j < 4; ++j) *(f32x4*)(orow + 256 * j) = v[j] * rstd * lg[j] + lb[j];
    }
}

constexpr int NPHASE = 10;
__global__ void __launch_bounds__(NTHREADS, 2) fwd(Args args) {
    extern __shared__ __attribute__((aligned(16))) unsigned char lds[];
    Frame F;
    F.lds = (LAS unsigned char*)lds; F.tid = threadIdx.x; F.lane = F.tid & 63; F.wave = __builtin_amdgcn_readfirstlane(F.tid >> 6);
    F.G = gridDim.x; F.bid = blockIdx.x; F.ws = args.ws; F.ctl = (unsigned*)(args.ws + WS_CTL); F.out = args.out;
    for (int u = F.tid; u < (LDS_BYTES - LDS_CTL) / 4; u += NTHREADS) ((LAS unsigned*)(F.lds + LDS_CTL))[u] = 0u;
    __syncthreads();
    XcdBarrier bar; bar.bar = F.ctl + CW_BAR; bar.x = 0; bar.st = nullptr;
    const bool multi = (args.ph_hi - args.ph_lo) > 1;
    if (multi) bar = xcd_barrier_post(F.ctl + CW_BAR, (volatile LAS unsigned*)(F.lds + LDS_CTL));
    const int lo = args.ph_lo, hi = args.ph_hi;
#ifndef PHASE_MASK
#define PHASE_MASK 0xFFFF
#endif
#define IN(k) (((PHASE_MASK >> (k)) & 1) && lo <= (k) && (k) < hi)
#define SEAM(k) do { if (IN(k) && IN((k) + 1)) xcd_barrier(bar); } while (0)
#define LAUNDER() do { asm volatile("" : "+s"(F.ws), "+s"(F.out), "+s"(F.ctl), "+v"(F.tid), "+v"(F.lane)); } while (0)
#ifndef REPEAT_PHASE
#define REPEAT_PHASE -1
#endif
#define RPT(k, stmt) do { stmt; if (REPEAT_PHASE == (k)) { __syncthreads(); stmt; } } while (0)
    if (IN(0)) { RPT(0, p0_prologue(F, args)); } SEAM(0);
    if (IN(1)) { RPT(1, p1_proj_fast(F, args)); } if (IN(1) && IN(3)) xcd_barrier(bar);
    if (IN(3)) { const int nrep = (REPEAT_PHASE == 3) ? (args.ph_hi > 0 ? 2 : 1) : 1;
#pragma unroll 1
        for (int rep = 0; rep < nrep; ++rep) { p2_attn_fast(F, args, rep * 1024); __syncthreads(); } } SEAM(3);
    if (IN(4)) { RPT(40, convert_experts(F, args)); __syncthreads(); RPT(4, p3_merge_fast(F, args)); } SEAM(4);
    if (IN(5)) { RPT(5, p4_out_fast(F, args)); } SEAM(5);
    if (IN(6)) { p5_ln_router_mfma<false>(F, args); if (REPEAT_PHASE == 6) { __syncthreads(); p5_ln_router_mfma<true>(F, args); } } SEAM(6);
    if (IN(7)) { RPT(7, p6_moe_up_fast(F, args)); } SEAM(7);
    if (IN(8)) { RPT(8, p7_moe_down_fast(F, args)); } SEAM(8);
    if (IN(9)) { RPT(9, p8_final(F, args)); }
#undef IN
#undef SEAM
}

extern "C" void kernel_launch(void* const* d_in, const int* in_sizes, int n_in, void* d_out, int out_size, void* d_ws, size_t ws_size, hipStream_t stream) {
    static int grid = 0;
    if (grid == 0) {
        if (n_in != 20 || in_sizes[0] != NTOK * DM || out_size != NTOK * DM || ws_size < WS_END) { fprintf(stderr, "kernel_launch: unexpected shapes (n_in %d, ws %zu)\n", n_in, ws_size); grid = -1; return; }
        int dev = 0, cus = 0, per_cu = 0;
        if (hipGetDevice(&dev) != hipSuccess || hipDeviceGetAttribute(&cus, hipDeviceAttributeMultiprocessorCount, dev) != hipSuccess) { grid = -1; return; }
        if (hipFuncSetAttribute((const void*)fwd, hipFuncAttributeMaxDynamicSharedMemorySize, LDS_BYTES) != hipSuccess) { fprintf(stderr, "kernel_launch: hipFuncSetAttribute failed\n"); grid = -1; return; }
        if (hipOccupancyMaxActiveBlocksPerMultiprocessor(&per_cu, (const void*)fwd, NTHREADS, LDS_BYTES) != hipSuccess || per_cu < 1) { fprintf(stderr, "kernel_launch: occupancy query says %d\n", per_cu); }
        (void)hipGetLastError();
        grid = cus;
    }
    if (grid < 0) return;
    if (hipMemsetAsync((char*)d_ws + WS_CTL, 0, CTL_ZERO_BYTES, stream) != hipSuccess) return;
    Args a{};
    for (int i = 0; i < 20; ++i) a.in[i] = (const float*)d_in[i];
    a.out = (float*)d_out; a.ws = (unsigned char*)d_ws;
#if N_LAUNCH_PER_PHASE
    for (int p = 0; p < NPHASE; ++p) { a.ph_lo = p; a.ph_hi = p + 1; hipLaunchKernelGGL(fwd, dim3(grid), dim3(NTHREADS), LDS_BYTES, stream, a); }
#else
    a.ph_lo = 0; a.ph_hi = NPHASE; hipLaunchKernelGGL(fwd, dim3(grid), dim3(NTHREADS), LDS_BYTES, stream, a);
#endif
}
```
